# Optimizing an MI355X kernel written in HIP

```python
import jax, jax.numpy as jnp
from jax import lax
import numpy as np

D_MODEL = 1024
BATCH = 8
SEQ = 4096
DEPTH = 4

HEAD_DIM = 64
N_NSA_HEADS = 8
N_NSA_KV = 2
NSA_GROUP = N_NSA_HEADS // N_NSA_KV
N_FOX_HEADS = 8
MIX_WIDTH = (N_NSA_HEADS + N_FOX_HEADS) * HEAD_DIM
N_BRANCH = 3
CMP_LEN = 32
CMP_STRIDE = 16
CMP_HIDDEN = 256
SEL_BLOCK = 64
SEL_TOPK = 16
WINDOW = 512
Q_BLOCK = 128
SEL_Q_BLOCK = 32
ROPE_THETA = 500000.0
ROPE_DIMS = HEAD_DIM // 4
D_FF = 4 * D_MODEL
NORM_EPS = 1e-6
NEG_INF = -1e30
FORCED_SCORE = 1e4
NSA_Q_COLS = N_NSA_HEADS * HEAD_DIM
KV_COLS = N_NSA_KV * HEAD_DIM
NSA_GATE_COLS = N_NSA_HEADS * N_BRANCH
FOX_COLS = N_FOX_HEADS * HEAD_DIM
FOX_F_COLS = N_FOX_HEADS
COL_SIZES = (NSA_Q_COLS, KV_COLS, KV_COLS, KV_COLS, KV_COLS, KV_COLS, KV_COLS, NSA_GATE_COLS, FOX_COLS, FOX_COLS, FOX_COLS, FOX_F_COLS)
IN_COLS = NSA_Q_COLS + 6 * KV_COLS + NSA_GATE_COLS + 3 * FOX_COLS + FOX_F_COLS

kernel_name = "nsa_fox_hymba_sandwich_trunk"


def _rms_norm(x, g):
    xf = x.astype(jnp.float32)
    y = xf * lax.rsqrt(jnp.mean(xf * xf, axis=-1, keepdims=True) + NORM_EPS)
    return (y * g.astype(jnp.float32)).astype(x.dtype)


def _partial_rope(x, pos):
    half = ROPE_DIMS // 2
    inv_freq = ROPE_THETA ** (-jnp.arange(half, dtype=jnp.float32) * 2.0 / ROPE_DIMS)
    ang = pos.astype(jnp.float32)[:, None] * inv_freq[None, :]
    cos, sin = jnp.cos(ang), jnp.sin(ang)
    xf = x.astype(jnp.float32)
    x1, x2 = xf[..., :half], xf[..., half:ROPE_DIMS]
    out = jnp.concatenate([x1 * cos - x2 * sin, x1 * sin + x2 * cos, xf[..., ROPE_DIMS:]], axis=-1)
    return out.astype(x.dtype)


def _masked_softmax(s, mask):
    return jax.nn.softmax(jnp.where(mask, s, NEG_INF), axis=-1)


def _unblock(t, axis):
    t = jnp.moveaxis(t, 0, axis)
    shp = t.shape
    return t.reshape(shp[:axis] + (shp[axis] * shp[axis + 1],) + shp[axis + 2:])


def _importance_map(seq):
    n_cmp = (seq - CMP_LEN) // CMP_STRIDE + 1
    n_sel = seq // SEL_BLOCK
    cs = np.arange(n_cmp)[:, None] * CMP_STRIDE
    ss = np.arange(n_sel)[None, :] * SEL_BLOCK
    overlap = np.clip(np.minimum(cs + CMP_LEN, ss + SEL_BLOCK) - np.maximum(cs, ss), 0, None)
    return jnp.asarray(overlap / CMP_LEN, dtype=jnp.float32)


def _compress(kv, pos_emb, w1, b1, w2, b2):
    b, g, s, d = kv.shape
    r = CMP_LEN // CMP_STRIDE
    n_chunk = s // CMP_STRIDE
    n_cmp = n_chunk - r + 1
    chunks = kv.reshape(b, g, n_chunk, CMP_STRIDE, d)
    blocks = jnp.concatenate([chunks[:, :, j:j + n_cmp] for j in range(r)], axis=3)
    blocks = (blocks + pos_emb).reshape(b, g, n_cmp, CMP_LEN * d)
    hid = jax.nn.gelu(blocks @ w1 + b1)
    return hid @ w2 + b2


def _nsa_mixer(q, k_c, v_c, k_s, v_s, k_w, v_w, gate_logits, gate_bias,
               pos_k, w1_k, b1_k, w2_k, b2_k, pos_v, w1_v, b1_v, w2_v, b2_v):
    b, s, _, d = q.shape
    pos = jnp.arange(s)
    scale = HEAD_DIM ** -0.5
    q = q.reshape(b, s, N_NSA_KV, NSA_GROUP, d).transpose(0, 2, 3, 1, 4)
    q_rot = _partial_rope(q, pos)
    k_c, v_c, k_s, v_s, k_w, v_w = (t.transpose(0, 2, 1, 3) for t in (k_c, v_c, k_s, v_s, k_w, v_w))
    kc = _compress(k_c, pos_k, w1_k, b1_k, w2_k, b2_k)
    vc = _compress(v_c, pos_v, w1_v, b1_v, w2_v, b2_v)
    n_cmp = kc.shape[2]
    cmp_end = jnp.arange(n_cmp) * CMP_STRIDE + CMP_LEN - 1
    imp_map = _importance_map(s)
    n_sel = s // SEL_BLOCK
    top_k = min(SEL_TOPK, n_sel)
    k_s_rot = _partial_rope(k_s, pos)
    pad = ((0, 0), (0, 0), (WINDOW, 0), (0, 0))
    k_w_pad = jnp.pad(_partial_rope(k_w, pos), pad)
    v_w_pad = jnp.pad(v_w, pad)
    blk = jnp.arange(n_sel)

    def block_fn(i):
        q0 = i * Q_BLOCK
        qpos = q0 + jnp.arange(Q_BLOCK)
        qp = lax.dynamic_slice_in_dim(q, q0, Q_BLOCK, axis=3)
        qr = lax.dynamic_slice_in_dim(q_rot, q0, Q_BLOCK, axis=3)
        sc = jnp.einsum('bghqd,bgnd->bghqn', qp, kc).astype(jnp.float32) * scale
        mc = cmp_end[None, :] <= qpos[:, None]
        pc = _masked_softmax(sc, mc) * mc
        o_cmp = jnp.einsum('bghqn,bgnd->bghqd', pc.astype(vc.dtype), vc)
        imp = jnp.einsum('bghqn,nj->bgqj', pc, imp_map)
        cur = qpos // SEL_BLOCK
        valid = blk[None, :] * SEL_BLOCK <= qpos[:, None]
        forced = (blk[None, :] == 0) | (blk[None, :] == cur[:, None]) | (blk[None, :] == cur[:, None] - 1)
        score = jnp.where(forced, FORCED_SCORE, jnp.where(valid, imp, -1.0))
        _, idx = lax.top_k(score, top_k)
        kw = lax.dynamic_slice_in_dim(k_w_pad, q0, WINDOW + Q_BLOCK, axis=2)
        vw = lax.dynamic_slice_in_dim(v_w_pad, q0, WINDOW + Q_BLOCK, axis=2)
        kpos = q0 - WINDOW + jnp.arange(WINDOW + Q_BLOCK)
        mw = (kpos[None, :] <= qpos[:, None]) & (kpos[None, :] > qpos[:, None] - WINDOW) & (kpos[None, :] >= 0)
        sw = jnp.einsum('bghqd,bgkd->bghqk', qr, kw).astype(jnp.float32) * scale
        pw = _masked_softmax(sw, mw)
        o_win = jnp.einsum('bghqk,bgkd->bghqd', pw.astype(vw.dtype), vw)
        return o_cmp, o_win, idx

    o_cmp, o_win, sel_idx = lax.map(block_fn, jnp.arange(s // Q_BLOCK))
    o_cmp = _unblock(o_cmp, 3)
    o_win = _unblock(o_win, 3)
    sel_idx = _unblock(sel_idx, 2)

    kb = k_s_rot.reshape(b, N_NSA_KV, n_sel, SEL_BLOCK, d)
    vb = v_s.reshape(b, N_NSA_KV, n_sel, SEL_BLOCK, d)
    gather = jax.vmap(jax.vmap(lambda blocks, ix: blocks[ix]))
    n_keys = top_k * SEL_BLOCK

    def sel_fn(c):
        q0 = c * SEL_Q_BLOCK
        qpos = q0 + jnp.arange(SEL_Q_BLOCK)
        qr = lax.dynamic_slice_in_dim(q_rot, q0, SEL_Q_BLOCK, axis=3)
        ix = lax.dynamic_slice_in_dim(sel_idx, q0, SEL_Q_BLOCK, axis=2)
        kg = gather(kb, ix)
        vg = gather(vb, ix).reshape(b, N_NSA_KV, SEL_Q_BLOCK, n_keys, d)
        kpos = ix[..., None] * SEL_BLOCK + jnp.arange(SEL_BLOCK)
        m = (kpos <= qpos[None, None, :, None, None]).reshape(b, N_NSA_KV, 1, SEL_Q_BLOCK, n_keys)
        ss = jnp.einsum('bghqd,bgqnkd->bghqnk', qr, kg).astype(jnp.float32) * scale
        ps = _masked_softmax(ss.reshape(b, N_NSA_KV, NSA_GROUP, SEL_Q_BLOCK, n_keys), m)
        return jnp.einsum('bghqm,bgqmd->bghqd', ps.astype(vg.dtype), vg)

    o_sel = _unblock(lax.map(sel_fn, jnp.arange(s // SEL_Q_BLOCK)), 3)

    g = jax.nn.sigmoid((gate_logits + gate_bias).astype(jnp.float32)).astype(q.dtype)
    g = g.reshape(b, s, N_NSA_KV, NSA_GROUP, N_BRANCH).transpose(0, 2, 3, 1, 4)
    o = g[..., 0:1] * o_cmp + g[..., 1:2] * o_sel + g[..., 2:3] * o_win
    return o.transpose(0, 3, 1, 2, 4).reshape(b, s, N_NSA_HEADS * d)


def _fox_mixer(q, k, v, f_logits, f_bias):
    b, s, h, d = q.shape
    scale = HEAD_DIM ** -0.5
    q, k, v = (t.transpose(0, 2, 1, 3) for t in (q, k, v))
    log_f = jax.nn.log_sigmoid(f_logits.astype(jnp.float32) + f_bias.astype(jnp.float32))
    cum = jnp.cumsum(log_f, axis=1).transpose(0, 2, 1)
    outs = []
    for i in range(s // Q_BLOCK):
        q0, q1 = i * Q_BLOCK, (i + 1) * Q_BLOCK
        logits = (jnp.einsum('bhqd,bhkd->bhqk', q[:, :, q0:q1], k[:, :, :q1]).astype(jnp.float32) * scale
                  + cum[:, :, q0:q1, None] - cum[:, :, None, :q1])
        mask = jnp.arange(q1)[None, :] <= jnp.arange(q0, q1)[:, None]
        p = _masked_softmax(logits, mask)
        outs.append(jnp.einsum('bhqk,bhkd->bhqd', p.astype(v.dtype), v[:, :, :q1]))
    o = jnp.concatenate(outs, axis=2)
    return o.transpose(0, 2, 1, 3).reshape(b, s, h * d)


def setup_inputs(seed: int = 0) -> dict:
    key = jax.random.key(seed)
    ks = jax.random.split(key, 22)
    f32 = jnp.float32
    nrm = lambda k, shape, fan_in: jax.random.normal(k, shape, f32) * (fan_in ** -0.5)
    small = lambda k, shape, sc: sc * jax.random.normal(k, shape, f32)
    gain = lambda k: 1.0 + 0.05 * jax.random.normal(k, (DEPTH, D_MODEL), f32)
    cmp_in = CMP_LEN * HEAD_DIM
    return {
        "x": jax.random.normal(ks[0], (BATCH, SEQ, D_MODEL), f32),
        "w_in": nrm(ks[1], (DEPTH, D_MODEL, IN_COLS), D_MODEL),
        "b_nsa_gate": small(ks[2], (DEPTH, NSA_GATE_COLS), 0.01),
        "b_forget": jax.random.uniform(ks[3], (DEPTH, N_FOX_HEADS), f32, minval=1.0, maxval=6.0),
        "cmp_pos_k": small(ks[4], (DEPTH, CMP_LEN, HEAD_DIM), 0.1),
        "cmp_w1_k": nrm(ks[5], (DEPTH, cmp_in, CMP_HIDDEN), cmp_in),
        "cmp_b1_k": small(ks[6], (DEPTH, CMP_HIDDEN), 0.01),
        "cmp_w2_k": nrm(ks[7], (DEPTH, CMP_HIDDEN, HEAD_DIM), CMP_HIDDEN),
        "cmp_b2_k": small(ks[8], (DEPTH, HEAD_DIM), 0.01),
        "cmp_pos_v": small(ks[9], (DEPTH, CMP_LEN, HEAD_DIM), 0.1),
        "cmp_w1_v": nrm(ks[10], (DEPTH, cmp_in, CMP_HIDDEN), cmp_in),
        "cmp_b1_v": small(ks[11], (DEPTH, CMP_HIDDEN), 0.01),
        "cmp_w2_v": nrm(ks[12], (DEPTH, CMP_HIDDEN, HEAD_DIM), CMP_HIDDEN),
        "cmp_b2_v": small(ks[13], (DEPTH, HEAD_DIM), 0.01),
        "w_out": nrm(ks[14], (DEPTH, MIX_WIDTH, D_MODEL), MIX_WIDTH),
        "w_up": nrm(ks[15], (DEPTH, D_MODEL, D_FF), D_MODEL),
        "w_down": nrm(ks[16], (DEPTH, D_FF, D_MODEL), D_FF),
        "g_pre_mix": gain(ks[17]),
        "g_post_mix": gain(ks[18]),
        "g_pre_mlp": gain(ks[19]),
        "g_post_mlp": gain(ks[20]),
    }


def reference(x, w_in, b_nsa_gate, b_forget, cmp_pos_k, cmp_w1_k, cmp_b1_k, cmp_w2_k, cmp_b2_k,
              cmp_pos_v, cmp_w1_v, cmp_b1_v, cmp_w2_v, cmp_b2_v, w_out, w_up, w_down,
              g_pre_mix, g_post_mix, g_pre_mlp, g_post_mlp):
    b, s, _ = x.shape
    split_at = [int(v) for v in np.cumsum(COL_SIZES)[:-1]]
    for l in range(DEPTH):
        h = _rms_norm(x, g_pre_mix[l])
        parts = jnp.split(h @ w_in[l], split_at, axis=-1)
        nq, kc, vc, ksel, vsel, kwin, vwin, gates, fq, fk, fv, ff = parts
        heads = lambda t, n: t.reshape(b, s, n, HEAD_DIM)
        o_nsa = _nsa_mixer(heads(nq, N_NSA_HEADS),
                           heads(kc, N_NSA_KV), heads(vc, N_NSA_KV),
                           heads(ksel, N_NSA_KV), heads(vsel, N_NSA_KV),
                           heads(kwin, N_NSA_KV), heads(vwin, N_NSA_KV),
                           gates, b_nsa_gate[l],
                           cmp_pos_k[l], cmp_w1_k[l], cmp_b1_k[l], cmp_w2_k[l], cmp_b2_k[l],
                           cmp_pos_v[l], cmp_w1_v[l], cmp_b1_v[l], cmp_w2_v[l], cmp_b2_v[l])
        o_fox = _fox_mixer(heads(fq, N_FOX_HEADS), heads(fk, N_FOX_HEADS), heads(fv, N_FOX_HEADS),
                           ff, b_forget[l])
        mix = jnp.concatenate([o_nsa, o_fox], axis=-1) @ w_out[l]
        x = x + _rms_norm(mix, g_post_mix[l])
        h = _rms_norm(x, g_pre_mlp[l])
        y = jnp.square(jax.nn.relu(h @ w_up[l])) @ w_down[l]
        x = x + _rms_norm(y, g_post_mlp[l])
    return x
```

```cpp
#include <hip/hip_runtime.h>
#include <hip/hip_cooperative_groups.h>
#include <cstdio>
#include <cstdint>
namespace cg = cooperative_groups;
namespace pg8 {
#define PG8_LAS __attribute__((address_space(3)))
typedef unsigned short bf16_t;
typedef short bf16x8 __attribute__((ext_vector_type(8)));
typedef float f32x4 __attribute__((ext_vector_type(4)));
typedef unsigned u32x4 __attribute__((ext_vector_type(4)));
constexpr int BM = 256, BK = 64, HALF = 128, HTB = HALF * BK * 2  , STAGE_BYTES = 8 * HTB, NXCD = 8, WGM = 8;

__host__ __device__ __forceinline__ int lds_byte(int r, int c) { const int st = (r >> 4) * 2 + (c >> 5), rr = r & 15, cc = c & 31, ob = rr * 64 + cc * 2; return st * 1024 + (ob ^ (((ob >> 9) & 1) << 5)); }
__host__ __device__ __forceinline__ void stage_rc(int b, int& R, int& C) { const int st = b / 1024, sb = b % 1024, swz = sb ^ (((sb >> 9) & 1) << 5); R = (st >> 1) * 16 + swz / 64; C = (st & 1) * 32 + (swz % 64) / 2; }
__host__ __device__ __forceinline__ int perm32(int rho) { const int n = rho >> 4, i = rho & 15; return 8 * (i >> 2) + 4 * n + (i & 3); }

struct Unit { int pm, pn; };
struct Gemm { const bf16_t* A; const bf16_t* Bt; int M, N, K, lda; };

struct StaticOrder {
    int nM, nN, nwg, G, c;
    __host__ __device__ void init(int M, int N, int G_, int c_) { nM = M / BM; nN = N / BM; nwg = nM * nN; G = G_; c = c_; }
    __host__ __device__ bool next(int i, Unit& u) const {
        const long L = (long)i * G + c; if (L >= nwg) return false;
        int wgid = (int)L; { const int q = nwg / NXCD, r = nwg % NXCD, xcd = wgid % NXCD, off = wgid / NXCD; wgid = (xcd < r ? xcd * (q + 1) : r * (q + 1) + (xcd - r) * q) + off; }
        const int nig = WGM * nN, gid = wgid / nig, fm = gid * WGM, gsz = (nM - fm) < WGM ? (nM - fm) : WGM;
        u.pm = fm + ((wgid % nig) % gsz); u.pn = (wgid % nig) / gsz; return true;
    }
    __device__ __forceinline__ void a_ready(const Unit&) const {}
    __device__ __forceinline__ void done(const Unit&) const {}
};

__device__ __forceinline__ unsigned cvt_pk_bf16(float lo, float hi) { unsigned r; asm volatile("v_cvt_pk_bf16_f32 %0, %1, %2" : "=v"(r) : "v"(lo), "v"(hi)); return r; }
template <class Epi, class Sched, bool ALIGN_EPI = false, bool SP2 = false>
__device__ __forceinline__ void gemm_phase(PG8_LAS unsigned char* lds, const Gemm g, const Sched& S, const Epi& E) {
    int tid_ = threadIdx.x; asm volatile("" : "+v"(tid_));
    const int tid = tid_, wid = __builtin_amdgcn_readfirstlane(tid >> 6), lane = tid & 63, wr = wid >> 2, wc = wid & 3, fr = lane & 15, fq = lane >> 4;
    const int K = g.K, nt = K / BK;
    unsigned voffA[2], voffB[2];
#pragma unroll
    for (int i = 0; i < 2; ++i) { int R, C; stage_rc(tid * 16 + i * 8192, R, C); const int Rb = Epi::PERM ? ((R & ~31) + perm32(R & 31)) : R;
        voffA[i] = (unsigned)(R * g.lda + C) * 2u; voffB[i] = (unsigned)(Rb * K + C) * 2u; }
    const size_t kstep = (size_t)(BK * 2);
    const size_t hstep = (size_t)HALF * K * 2;
    const size_t tstep = 2 * hstep; const size_t hstepA = (size_t)HALF * g.lda * 2, tstepA = 2 * hstepA;
    const unsigned ldsw = (unsigned)wid * 1024u;
    const int aoff = lds_byte(wr * 64 + fr, fq * 8), boff = lds_byte(wc * 32 + fr, fq * 8);
#define PG8_SA(b, h) (((b) * 2 + (h)) * HTB)
#define PG8_SB(b, h) ((4 + (b) * 2 + (h)) * HTB)
#define PG8_STAGE(bufoff, gbase, voff) do { _Pragma("unroll") for (int _i = 0; _i < 2; ++_i) \
        __builtin_amdgcn_global_load_lds((const unsigned*)((const char*)(gbase) + (voff)[_i]), (PG8_LAS unsigned*)(lds + (bufoff) + ldsw + _i * 8192), 16, 0, 0); } while (0)
#define PG8_LDA(dst, b, h) do { _Pragma("unroll") for (int m = 0; m < 4; ++m) _Pragma("unroll") for (int k = 0; k < 2; ++k) dst[m][k] = *(const PG8_LAS bf16x8*)(lds + PG8_SA(b, h) + aoff + m * 2048 + k * 1024); } while (0)
#define PG8_LDB(dst, b, h) do { _Pragma("unroll") for (int n = 0; n < 2; ++n) _Pragma("unroll") for (int k = 0; k < 2; ++k) dst[n][k] = *(const PG8_LAS bf16x8*)(lds + PG8_SB(b, h) + boff + n * 2048 + k * 1024); } while (0)
#define PG8_MMA(ai, bj, At, Bt) do { __builtin_amdgcn_s_setprio(1); _Pragma("unroll") for (int m = 0; m < 4; ++m) _Pragma("unroll") for (int n = 0; n < 2; ++n) _Pragma("unroll") for (int k = 0; k < 2; ++k) \
        acc[ai][bj][m][n] = __builtin_amdgcn_mfma_f32_16x16x32_bf16(Bt[n][k], At[m][k], acc[ai][bj][m][n], 0, 0, 0); __builtin_amdgcn_s_setprio(0); } while (0)
#define PG8_WAIT_V(n) asm volatile("s_waitcnt vmcnt(" #n ")" ::: "memory")
#define PG8_WAIT_L(n) asm volatile("s_waitcnt lgkmcnt(" #n ")" ::: "memory")
#define PG8_BAR __builtin_amdgcn_s_barrier()
#define PG8_SCHED __builtin_amdgcn_sched_barrier(0)
    Unit cur, nxt; int ui = 0;
    if (!S.next(0, cur)) return;
    f32x4 acc[2][2][4][2];
#pragma unroll
    for (int a = 0; a < 2; ++a)
#pragma unroll
        for (int b = 0; b < 2; ++b)
#pragma unroll
            for (int m = 0; m < 4; ++m)
#pragma unroll
                for (int n = 0; n < 2; ++n) acc[a][b][m][n] = (f32x4){0.f, 0.f, 0.f, 0.f};
    bf16x8 At[4][2], B0[2][2], B1[2][2];
    const char* cA = (const char*)g.A + (size_t)cur.pm * tstepA; const char* cB = (const char*)g.Bt + (size_t)cur.pn * tstep;
    S.a_ready(cur);
    if constexpr (SP2) {
        PG8_STAGE(PG8_SB(0, 0), cB, voffB); PG8_STAGE(PG8_SB(0, 1), cB + hstep, voffB); PG8_STAGE(PG8_SA(0, 0), cA, voffA); PG8_STAGE(PG8_SA(0, 1), cA + hstepA, voffA);
        if (wr == 1) PG8_BAR;
        PG8_WAIT_V(2); PG8_BAR;
        PG8_STAGE(PG8_SB(1, 0), cB + kstep, voffB); PG8_STAGE(PG8_SA(1, 0), cA + kstep, voffA); PG8_STAGE(PG8_SB(1, 1), cB + hstep + kstep, voffB);
        PG8_WAIT_V(6); PG8_BAR;
    } else {
        PG8_STAGE(PG8_SB(0, 0), cB, voffB); PG8_STAGE(PG8_SA(0, 0), cA, voffA); PG8_STAGE(PG8_SB(0, 1), cB + hstep, voffB); PG8_STAGE(PG8_SA(0, 1), cA + hstepA, voffA);
        if (wr == 1) PG8_BAR;
        PG8_WAIT_V(4); PG8_BAR;
        PG8_STAGE(PG8_SB(1, 0), cB + kstep, voffB); PG8_STAGE(PG8_SA(1, 0), cA + kstep, voffA); PG8_STAGE(PG8_SB(1, 1), cB + hstep + kstep, voffB);
        PG8_WAIT_V(6); PG8_BAR;
    }
    for (;;) {
        const bool has_next = S.next(ui + 1, nxt);
        const char* nA = has_next ? (const char*)g.A + (size_t)nxt.pm * tstepA : cA; const char* nB = has_next ? (const char*)g.Bt + (size_t)nxt.pn * tstep : cB;
        for (int t = 0; t < nt; t += 2) {
            const bool last = (t == nt - 2);
            const char* a1 = cA + (size_t)(t + 1) * kstep;
            const char* a2 = last ? nA : cA + (size_t)(t + 2) * kstep; const char* b2 = last ? nB : cB + (size_t)(t + 2) * kstep;
            const char* a3 = a2 + kstep; const char* b3 = b2 + kstep;
            if (last && has_next) S.a_ready(nxt);
            if constexpr (SP2) {
            PG8_LDB(B0, 0, 0); PG8_LDB(B1, 0, 1); PG8_SCHED; PG8_LDA(At, 0, 0); PG8_STAGE(PG8_SA(1, 1), a1 + hstepA, voffA);
            PG8_WAIT_V(8); PG8_WAIT_L(0); PG8_BAR; PG8_MMA(0, 0, At, B0); PG8_MMA(0, 1, At, B1); PG8_BAR; PG8_SCHED;
            PG8_LDA(At, 0, 1); PG8_STAGE(PG8_SB(0, 0), b2, voffB); PG8_STAGE(PG8_SB(0, 1), b2 + hstep, voffB); PG8_STAGE(PG8_SA(0, 0), a2, voffA);
            PG8_WAIT_V(8); PG8_WAIT_L(0); PG8_BAR; PG8_MMA(1, 0, At, B0); PG8_MMA(1, 1, At, B1); PG8_BAR; PG8_SCHED;
            PG8_LDB(B0, 1, 0); PG8_LDB(B1, 1, 1); PG8_SCHED; PG8_LDA(At, 1, 0); PG8_STAGE(PG8_SA(0, 1), a2 + hstepA, voffA);
            PG8_WAIT_V(8); PG8_WAIT_L(0); PG8_BAR; PG8_MMA(0, 0, At, B0); PG8_MMA(0, 1, At, B1); PG8_BAR; PG8_SCHED;
            PG8_LDA(At, 1, 1); PG8_STAGE(PG8_SB(1, 0), b3, voffB); PG8_STAGE(PG8_SB(1, 1), b3 + hstep, voffB); PG8_STAGE(PG8_SA(1, 0), a3, voffA);
            PG8_WAIT_V(8); PG8_WAIT_L(0); PG8_BAR; PG8_MMA(1, 0, At, B0); PG8_MMA(1, 1, At, B1); PG8_BAR; PG8_SCHED;
            } else {
            PG8_LDB(B0, 0, 0); PG8_SCHED; PG8_LDA(At, 0, 0); PG8_STAGE(PG8_SA(1, 1), a1 + hstepA, voffA);
            PG8_WAIT_L(8); PG8_BAR; PG8_WAIT_L(0); PG8_MMA(0, 0, At, B0); PG8_BAR; PG8_SCHED;
            PG8_LDB(B1, 0, 1); PG8_STAGE(PG8_SB(0, 0), b2, voffB);
            PG8_BAR; PG8_WAIT_L(0); PG8_MMA(0, 1, At, B1); PG8_BAR;
            PG8_LDA(At, 0, 1); PG8_STAGE(PG8_SA(0, 0), a2, voffA);
            PG8_BAR; PG8_WAIT_L(0); PG8_MMA(1, 0, At, B0); PG8_BAR; PG8_SCHED;
            PG8_STAGE(PG8_SB(0, 1), b2 + hstep, voffB);
            PG8_WAIT_V(6); PG8_BAR; PG8_MMA(1, 1, At, B1); PG8_BAR;
            PG8_LDB(B0, 1, 0); PG8_SCHED; PG8_LDA(At, 1, 0); PG8_STAGE(PG8_SA(0, 1), a2 + hstepA, voffA);
            PG8_WAIT_L(8); PG8_BAR; PG8_WAIT_L(0); PG8_MMA(0, 0, At, B0); PG8_BAR; PG8_SCHED;
            PG8_LDB(B1, 1, 1); PG8_STAGE(PG8_SB(1, 0), b3, voffB);
            PG8_BAR; PG8_WAIT_L(0); PG8_MMA(0, 1, At, B1); PG8_BAR;
            PG8_LDA(At, 1, 1); PG8_STAGE(PG8_SA(1, 0), a3, voffA);
            PG8_BAR; PG8_WAIT_L(0); PG8_MMA(1, 0, At, B0); PG8_BAR; PG8_SCHED;
            PG8_STAGE(PG8_SB(1, 1), b3 + hstep, voffB);
            PG8_WAIT_V(6); PG8_BAR; PG8_MMA(1, 1, At, B1); PG8_BAR;
            }
        }
        if constexpr (ALIGN_EPI) { if (wr == 0) PG8_BAR; }
        if constexpr (!Epi::AFTER_DRAIN) { E(acc, cur, wr, wc, fr, fq); S.done(cur); }
        if (!has_next) break;
#pragma unroll
        for (int a = 0; a < 2; ++a)
#pragma unroll
            for (int b = 0; b < 2; ++b)
#pragma unroll
                for (int m = 0; m < 4; ++m)
#pragma unroll
                    for (int n = 0; n < 2; ++n) acc[a][b][m][n] = (f32x4){0.f, 0.f, 0.f, 0.f};
        cur = nxt; cA = nA; cB = nB; ++ui;
        if constexpr (ALIGN_EPI) { if (wr == 1) PG8_BAR; }
    }
    PG8_WAIT_V(0);
    if constexpr (!ALIGN_EPI) { if (wr == 0) PG8_BAR; }
    PG8_BAR;
    if constexpr (Epi::AFTER_DRAIN) { E.fused(acc, cur, wr, wc, fr, fq, lds, wid, lane); S.done(cur); }
#undef PG8_SA
#undef PG8_SB
#undef PG8_STAGE
#undef PG8_LDA
#undef PG8_LDB
#undef PG8_MMA
#undef PG8_WAIT_V
#undef PG8_WAIT_L
#undef PG8_BAR
#undef PG8_SCHED
}
}

constexpr int T_TOK = 32768, SEQ = 4096, DM = 1024, NLAYER = 4, DFF = 4096;
constexpr int NA = 2304, NB = 768, WIN_COLS = 2848;
constexpr float LOG2E = 1.4426950408889634f;
constexpr float QSCALE = 0.125f * LOG2E;
constexpr float NORM_EPS = 1e-6f;
constexpr size_t MiB = 1u << 20;
constexpr size_t WS_CTL = 0;
constexpr size_t WS_WA = 1 * MiB, WS_WB = WS_WA + (size_t)NA * DM * 2, WS_WO = 7 * MiB, WS_WUP = 9 * MiB, WS_WDN = 17 * MiB;
constexpr size_t WS_W1K = 25 * MiB, WS_W1V = 26 * MiB, WS_W2K = 27 * MiB, WS_W2V = WS_W2K + 131072, WS_C1 = WS_W2V + 131072, WS_ROPE = 27 * MiB + 512 * 1024;
constexpr size_t WS_HB = 28 * MiB, WS_Y = 92 * MiB, WS_BIG = 220 * MiB;
constexpr size_t WS_QN = WS_BIG, WS_QR = WS_BIG + 32 * MiB, WS_FQ = WS_BIG + 64 * MiB, WS_FK = WS_BIG + 96 * MiB, WS_KS = WS_BIG + 128 * MiB, WS_KW = WS_BIG + 136 * MiB;
constexpr size_t WS_KC = WS_BIG + 144 * MiB, WS_VC = WS_BIG + 153 * MiB, WS_VT = WS_BIG + 162 * MiB, WS_U = WS_BIG;
constexpr size_t WS_GATES = 476 * MiB, WS_LOGF = 479 * MiB, WS_CUM = 480 * MiB, WS_KCC = 481 * MiB, WS_VCCT = WS_KCC + 512 * 1024, WS_HIDK = 482 * MiB, WS_HIDV = 484 * MiB, WS_END = 486 * MiB;
static_assert(WS_WB + (size_t)NB * DM * 2 <= WS_WO && WS_VT + (size_t)NB * T_TOK * 2 <= WS_BIG + 256 * MiB, "ws map");
constexpr int LDS_BYTES = 131072 + 1024;

#define LAS __attribute__((address_space(3)))
typedef unsigned short bf16_t;
typedef short bf16x8 __attribute__((ext_vector_type(8)));
typedef float f32x4 __attribute__((ext_vector_type(4)));
typedef float f32x16 __attribute__((ext_vector_type(16)));
typedef unsigned u32x4 __attribute__((ext_vector_type(4)));
typedef unsigned u32x2 __attribute__((ext_vector_type(2)));
typedef LAS unsigned char* lptr;

namespace pg8 {
__device__ __forceinline__ float gelu_tanh(float x) {
    const float u = 0.7978845608028654f * (x + 0.044715f * x * x * x);
    const float e = __expf(2.f * u);
    const float th = 1.f - 2.f / (e + 1.f);
    return 0.5f * x * (1.f + th);
}
template <int ACT> struct EpiStoreBf16 {
    static constexpr bool PERM = true, AFTER_DRAIN = false;
    bf16_t* O; size_t ldc; const float* bias;
    __device__ __forceinline__ void operator()(const f32x4 (&acc)[2][2][4][2], const Unit& u, int wr, int wc, int fr, int fq) const {
        asm volatile("" : "+v"(fr), "+v"(fq));
        const int row0 = u.pm * BM + wr * 64 + fr, col0 = u.pn * BM + wc * 32 + 8 * fq;
#pragma unroll
        for (int bj = 0; bj < 2; ++bj) {
            f32x4 b0 = (f32x4){0.f, 0.f, 0.f, 0.f}, b1 = b0;
            if (ACT == 2) { b0 = *(const f32x4*)(bias + col0 + bj * HALF); b1 = *(const f32x4*)(bias + col0 + bj * HALF + 4); }
#pragma unroll
            for (int ai = 0; ai < 2; ++ai)
#pragma unroll
                for (int m = 0; m < 4; ++m) {
                    f32x4 v0 = acc[ai][bj][m][0], v1 = acc[ai][bj][m][1];
                    if (ACT == 1) {
#pragma unroll
                        for (int e = 0; e < 4; ++e) { float a = fmaxf(v0[e], 0.f), b = fmaxf(v1[e], 0.f); v0[e] = a * a; v1[e] = b * b; }
                    }
                    if (ACT == 2) {
                        v0 += b0; v1 += b1;
#pragma unroll
                        for (int e = 0; e < 4; ++e) { v0[e] = gelu_tanh(v0[e]); v1[e] = gelu_tanh(v1[e]); }
                    }
                    u32x4 w; w.x = cvt_pk_bf16(v0[0], v0[1]); w.y = cvt_pk_bf16(v0[2], v0[3]); w.z = cvt_pk_bf16(v1[0], v1[1]); w.w = cvt_pk_bf16(v1[2], v1[3]);
                    *(u32x4*)(O + (size_t)(row0 + ai * HALF + m * 16) * ldc + col0 + bj * HALF) = w;
                }
        }
    }
};
struct EpiStoreF32 {
    static constexpr bool PERM = false, AFTER_DRAIN = false;
    float* O; size_t ldc;
    __device__ __forceinline__ void operator()(const f32x4 (&acc)[2][2][4][2], const Unit& u, int wr, int wc, int fr, int fq) const {
        asm volatile("" : "+v"(fr), "+v"(fq));
        const int row0 = u.pm * BM + wr * 64 + fr, col0 = u.pn * BM + wc * 32 + 4 * fq;
#pragma unroll
        for (int ai = 0; ai < 2; ++ai)
#pragma unroll
            for (int m = 0; m < 4; ++m) {
                float* rp = O + (size_t)(row0 + ai * HALF + m * 16) * ldc + col0;
#pragma unroll
                for (int bj = 0; bj < 2; ++bj)
#pragma unroll
                    for (int n = 0; n < 2; ++n) *(f32x4*)(rp + bj * HALF + n * 16) = acc[ai][bj][m][n];
            }
    }
};
struct EpiCmp2 {
    static constexpr bool PERM = false, AFTER_DRAIN = false;
    bf16_t* O; const float* b2; int transposed;
    __device__ __forceinline__ void operator()(const f32x4 (&acc)[2][2][4][2], const Unit& u, int wr, int wc, int fr, int fq) const {
        asm volatile("" : "+v"(fr), "+v"(fq));
        if (wc >= 2 || u.pn != 0) return;
#pragma unroll
        for (int n = 0; n < 2; ++n) {
            const int c0 = wc * 32 + 16 * n + 4 * fq;
            const f32x4 bv = *(const f32x4*)(b2 + c0);
#pragma unroll
            for (int ai = 0; ai < 2; ++ai)
#pragma unroll
                for (int m = 0; m < 4; ++m) {
                    const int row = u.pm * BM + ai * HALF + wr * 64 + m * 16 + fr, bg = row >> 8, nn = row & 255;
                    f32x4 v = acc[ai][0][m][n] + bv;
                    if (nn == 255) v = (f32x4){0.f, 0.f, 0.f, 0.f};
                    if (!transposed) { u32x2 w; w.x = cvt_pk_bf16(v[0], v[1]); w.y = cvt_pk_bf16(v[2], v[3]); *(u32x2*)(O + (size_t)row * 64 + c0) = w; }
                    else {
#pragma unroll
                        for (int e = 0; e < 4; ++e) O[((size_t)bg * 64 + c0 + e) * 256 + nn] = (bf16_t)(cvt_pk_bf16(v[e], 0.f) & 0xffffu);
                    }
                }
        }
    }
};
struct EpiIn {
    static constexpr bool PERM = true, AFTER_DRAIN = false;
    unsigned char* ws; const float* bgate; const float* bforget;
    static __device__ __forceinline__ u32x4 pack8(const f32x4& a, const f32x4& b, float s) {
        u32x4 w; w.x = cvt_pk_bf16(a[0] * s, a[1] * s); w.y = cvt_pk_bf16(a[2] * s, a[3] * s); w.z = cvt_pk_bf16(b[0] * s, b[1] * s); w.w = cvt_pk_bf16(b[2] * s, b[3] * s); return w;
    }
    __device__ __forceinline__ void rope8(f32x4& v0, f32x4& v1, int t, int fq) const {
        f32x4 p0, p1;
#pragma unroll
        for (int e = 0; e < 4; ++e) { p0[e] = __shfl_xor(v0[e], 16); p1[e] = __shfl_xor(v1[e], 16); }
        const f32x4* tb = (const f32x4*)((const float*)(ws + WS_ROPE) + (size_t)t * 16);
        const f32x4 c01 = tb[0], c23 = tb[1], c45 = tb[2], c67 = tb[3];
        f32x4 cA, sA, cB, sB;
        cA[0] = c01[0]; sA[0] = c01[1]; cA[1] = c01[2]; sA[1] = c01[3]; cA[2] = c23[0]; sA[2] = c23[1]; cA[3] = c23[2]; sA[3] = c23[3];
        cB[0] = c45[0]; sB[0] = c45[1]; cB[1] = c45[2]; sB[1] = c45[3]; cB[2] = c67[0]; sB[2] = c67[1]; cB[3] = c67[2]; sB[3] = c67[3];
        if (fq == 0) { v0 = v0 * cA - p0 * sA; v1 = v1 * cB - p1 * sB; }
        else if (fq == 1) { v0 = p0 * sA + v0 * cA; v1 = p1 * sB + v1 * cB; }
    }
    template <int CLS, int bj>
    __device__ __forceinline__ void emit(const f32x4 (&acc)[2][2][4][2], const Unit& u, int wr, int wc, int fr, int fq, int hc, int dl) const {
        const bool ropew = (wc & 1) == 0;
        bf16_t* QN = (bf16_t*)(ws + WS_QN); bf16_t* QR = (bf16_t*)(ws + WS_QR); bf16_t* KC = (bf16_t*)(ws + WS_KC); bf16_t* VC = (bf16_t*)(ws + WS_VC); bf16_t* KS = (bf16_t*)(ws + WS_KS); bf16_t* KW = (bf16_t*)(ws + WS_KW);
        bf16_t* FQ = (bf16_t*)(ws + WS_FQ); bf16_t* FK = (bf16_t*)(ws + WS_FK); float* GATES = (float*)(ws + WS_GATES); float* LOGF = (float*)(ws + WS_LOGF);
        (void)QN; (void)QR; (void)KC; (void)VC; (void)KS; (void)KW; (void)FQ; (void)FK; (void)GATES; (void)LOGF; (void)ropew;
#pragma unroll
        for (int ai = 0; ai < 2; ++ai)
#pragma unroll
            for (int m = 0; m < 4; ++m) {
                const int row = u.pm * BM + ai * HALF + wr * 64 + m * 16 + fr;
                const int bb = row >> 12, t = row & 4095;
                f32x4 v0 = acc[ai][bj][m][0], v1 = acc[ai][bj][m][1];
                if (CLS == 0) {
                    const size_t off = (size_t)row * 512 + hc * 64 + dl;
                    *(u32x4*)(QN + off) = pack8(v0, v1, QSCALE);
                    if (ropew) rope8(v0, v1, t, fq);
                    *(u32x4*)(QR + off) = pack8(v0, v1, QSCALE);
                } else if (CLS == 1) {
                    bf16_t* B = (hc < 10) ? KC : VC;
                    *(u32x4*)(B + ((size_t)(bb * 2 + (hc & 1)) * 4096 + t) * 64 + dl) = pack8(v0, v1, 1.f);
                } else if (CLS == 2) {
                    bf16_t* B = (hc < 14) ? KS : KW;
                    if (ropew) rope8(v0, v1, t, fq);
                    *(u32x4*)(B + (size_t)row * 128 + (hc & 1) * 64 + dl) = pack8(v0, v1, 1.f);
                } else if (CLS == 3) {
                    *(u32x4*)(FQ + (size_t)row * 512 + (hc - 16) * 64 + dl) = pack8(v0, v1, QSCALE);
                } else if (CLS == 4) {
                    *(u32x4*)(FK + (size_t)row * 512 + (hc - 24) * 64 + dl) = pack8(v0, v1, 1.f);
                } else {
                    if (fq < 3) {
                        const f32x4 g0 = *(const f32x4*)(bgate + 8 * fq), g1 = *(const f32x4*)(bgate + 8 * fq + 4);
                        f32x4 o0, o1;
#pragma unroll
                        for (int e = 0; e < 4; ++e) { o0[e] = 1.f / (1.f + __expf(-(v0[e] + g0[e]))); o1[e] = 1.f / (1.f + __expf(-(v1[e] + g1[e]))); }
                        *(f32x4*)(GATES + (size_t)row * 24 + 8 * fq) = o0; *(f32x4*)(GATES + (size_t)row * 24 + 8 * fq + 4) = o1;
                    } else {
                        const f32x4 g0 = *(const f32x4*)(bforget), g1 = *(const f32x4*)(bforget + 4);
                        f32x4 o0, o1;
#pragma unroll
                        for (int e = 0; e < 4; ++e) {
                            const float a = v0[e] + g0[e], b = v1[e] + g1[e];
                            o0[e] = fminf(a, 0.f) - log1pf(__expf(-fabsf(a))); o1[e] = fminf(b, 0.f) - log1pf(__expf(-fabsf(b)));
                        }
                        *(f32x4*)(LOGF + (size_t)row * 8) = o0; *(f32x4*)(LOGF + (size_t)row * 8 + 4) = o1;
                    }
                }
                asm volatile("" ::: "memory");
                __builtin_amdgcn_sched_barrier(0);
            }
    }
    template <int bj>
    __device__ __forceinline__ void half(const f32x4 (&acc)[2][2][4][2], const Unit& u, int wr, int wc, int fr, int fq) const {
        const int colb = u.pn * BM + bj * HALF + wc * 32, hc = colb >> 6;
        const int dl = (colb & 63) + 8 * fq;
        if (hc < 8) emit<0, bj>(acc, u, wr, wc, fr, fq, hc, dl);
        else if (hc < 12) emit<1, bj>(acc, u, wr, wc, fr, fq, hc, dl);
        else if (hc < 16) emit<2, bj>(acc, u, wr, wc, fr, fq, hc, dl);
        else if (hc < 24) emit<3, bj>(acc, u, wr, wc, fr, fq, hc, dl);
        else if (hc < 32) emit<4, bj>(acc, u, wr, wc, fr, fq, hc, dl);
        else if (hc == 32 && wc == 0) emit<5, bj>(acc, u, wr, wc, fr, fq, hc, dl);
    }
    __device__ __forceinline__ void operator()(const f32x4 (&acc)[2][2][4][2], const Unit& u, int wr, int wc, int fr, int fq) const {
        asm volatile("" : "+v"(fr), "+v"(fq));
        half<0>(acc, u, wr, wc, fr, fq);
        half<1>(acc, u, wr, wc, fr, fq);
    }
};
struct RangeOrder {
    int nM, nN, G, cc;
    __device__ void init(int M, int N, int G_, int c, int c0) { nM = M / BM; nN = N / BM; G = G_; cc = ((c - c0) % G_ + G_) % G_; }
    __device__ bool next(int i, Unit& u) const { const long L = (long)i * G + cc; if (L >= (long)nM * nN) return false; u.pm = (int)(L % nM); u.pn = (int)(L / nM); return true; }
    __device__ __forceinline__ void a_ready(const Unit&) const {}
    __device__ __forceinline__ void done(const Unit&) const {}
};
}

namespace att {
typedef float f32x2_t __attribute__((ext_vector_type(2)));
typedef __bf16 bf16x2_t __attribute__((ext_vector_type(2)));
constexpr int KROW = 144, TILEB = 64 * KROW;
constexpr int L_K = 0, L_V = 2 * TILEB, L_CK = 4 * TILEB, L_SELM = L_CK + 512, L_UNIT = L_SELM + 512, L_TOPK = L_UNIT + 64, L_IMP = 40960, L_END = L_IMP + 65536;
static_assert(L_TOPK + 2048 <= L_IMP && L_END <= 131072, "attention LDS map");
#define NEG_INF_F (-__builtin_inff())
__device__ __forceinline__ unsigned cvtpk(float lo, float hi) { f32x2_t v = {lo, hi}; bf16x2_t b = __builtin_convertvector(v, bf16x2_t); return __builtin_bit_cast(unsigned, b); }
__device__ __forceinline__ float hmax(float v) { auto rr = __builtin_amdgcn_permlane32_swap(__float_as_uint(v), __float_as_uint(v), false, false); return fmaxf(__uint_as_float(rr[0]), __uint_as_float(rr[1])); }
__device__ __forceinline__ float hsum(float v) { auto rr = __builtin_amdgcn_permlane32_swap(__float_as_uint(v), __float_as_uint(v), false, false); return __uint_as_float(rr[0]) + __uint_as_float(rr[1]); }
#define MFMA32(a, b, c) __builtin_amdgcn_mfma_f32_32x32x16_bf16((a), (b), (c), 0, 0, 0)

struct St { float m, l; f32x16 o0, o1; };
__device__ __forceinline__ void st_init(St& s) { s.m = -1e30f; s.l = 0.f; s.o0 = (f32x16){}; s.o1 = (f32x16){}; }

template <bool FOXB>
__device__ __forceinline__ void tile_qk(f32x16& s0, f32x16& s1, lptr kb, lptr ck, const bf16x8 (&qf)[4], int koff, int hh) {
    s0 = (f32x16){}; s1 = (f32x16){};
#pragma unroll
    for (int d0 = 0; d0 < 4; ++d0) {
        const bf16x8 a0 = *(const LAS bf16x8*)(kb + koff + d0 * 32);
        const bf16x8 a1 = *(const LAS bf16x8*)(kb + koff + 32 * KROW + d0 * 32);
        s0 = MFMA32(a0, qf[d0], s0); s1 = MFMA32(a1, qf[d0], s1);
    }
    if (FOXB) {
#pragma unroll
        for (int g = 0; g < 4; ++g) {
            const f32x4 c0 = *(const LAS f32x4*)(ck + 64 * hh + 16 * g), c1 = *(const LAS f32x4*)(ck + 128 + 64 * hh + 16 * g);
#pragma unroll
            for (int e = 0; e < 4; ++e) { s0[4 * g + e] -= c0[e]; s1[4 * g + e] -= c1[e]; }
        }
    }
}
__device__ __forceinline__ void tile_mask(f32x16& s0, f32x16& s1, int thr_le, int thr_gt, int hh) {
    const int b0 = 16 * hh;
#pragma unroll
    for (int r = 0; r < 16; ++r) {
        const int k0 = b0 + r, k1 = b0 + 32 + r;
        s0[r] = (k0 <= thr_le && k0 > thr_gt) ? s0[r] : NEG_INF_F;
        s1[r] = (k1 <= thr_le && k1 > thr_gt) ? s1[r] : NEG_INF_F;
    }
}
__device__ __forceinline__ void tile_softmax_pv(f32x16& s0, f32x16& s1, St& st, lptr vb, int voff) {
    float mx = fmaxf(s0[0], s1[0]);
#pragma unroll
    for (int r = 1; r < 16; ++r) mx = fmaxf(mx, fmaxf(s0[r], s1[r]));
    mx = hmax(mx);
    const float mn = fmaxf(st.m, mx), alpha = __builtin_amdgcn_exp2f(st.m - mn);
    st.m = mn;
    float rs = 0.f;
#pragma unroll
    for (int r = 0; r < 16; ++r) { s0[r] = __builtin_amdgcn_exp2f(s0[r] - mn); s1[r] = __builtin_amdgcn_exp2f(s1[r] - mn); rs += s0[r] + s1[r]; }
    st.l = st.l * alpha + rs;
    if (__any(alpha != 1.f)) { st.o0 *= alpha; st.o1 *= alpha; }
#pragma unroll
    for (int kbk = 0; kbk < 2; ++kbk)
#pragma unroll
        for (int s = 0; s < 2; ++s) {
            u32x4 pw;
            if (kbk == 0) { pw.x = cvtpk(s0[8 * s], s0[8 * s + 1]); pw.y = cvtpk(s0[8 * s + 2], s0[8 * s + 3]); pw.z = cvtpk(s0[8 * s + 4], s0[8 * s + 5]); pw.w = cvtpk(s0[8 * s + 6], s0[8 * s + 7]); }
            else          { pw.x = cvtpk(s1[8 * s], s1[8 * s + 1]); pw.y = cvtpk(s1[8 * s + 2], s1[8 * s + 3]); pw.z = cvtpk(s1[8 * s + 4], s1[8 * s + 5]); pw.w = cvtpk(s1[8 * s + 6], s1[8 * s + 7]); }
            const bf16x8 p = __builtin_bit_cast(bf16x8, pw);
            const bf16x8 a0 = *(const LAS bf16x8*)(vb + voff + kbk * 64 + s * 16);
            const bf16x8 a1 = *(const LAS bf16x8*)(vb + voff + 32 * KROW + kbk * 64 + s * 16);
            st.o0 = MFMA32(a0, p, st.o0); st.o1 = MFMA32(a1, p, st.o1);
        }
}
__device__ __forceinline__ void tile_imp(const f32x16& s0, const f32x16& s1, float m, float minv, int thr, int t, lptr impw, int r32, int hh) {
#pragma unroll
    for (int kbk = 0; kbk < 2; ++kbk) {
        float p[16];
#pragma unroll
        for (int r = 0; r < 16; ++r) { const float sv = kbk ? s1[r] : s0[r]; const int kl = 32 * kbk + 16 * hh + r; p[r] = (kl <= thr) ? __builtin_amdgcn_exp2f(sv - m) * minv : 0.f; }
        f32x4 add;
        add[0] = p[0] + p[1] + p[2] + 0.5f * p[3];
        add[1] = p[4] + p[5] + p[6] + 0.5f * p[7] + 0.5f * p[3];
        add[2] = p[8] + p[9] + p[10] + 0.5f * p[11] + 0.5f * p[7];
        add[3] = p[12] + p[13] + p[14] + 0.5f * p[15] + 0.5f * p[11];
        const float carry = 0.5f * p[15];
        const int j0 = 16 * t + 8 * kbk + 4 * hh;
        LAS f32x4* ip = (LAS f32x4*)(impw + (r32 * 64 + j0) * 4);
        f32x4 cur = *ip; cur += add; *ip = cur;
        asm volatile("s_waitcnt lgkmcnt(0)" ::: "memory");
        if (j0 + 4 < 64) { LAS float* cp = (LAS float*)(impw + (r32 * 64 + j0 + 4) * 4); const float c = *cp; *cp = c + carry; }
        asm volatile("s_waitcnt lgkmcnt(0)" ::: "memory");
    }
}

struct TP { const bf16_t* Kg; int kstride; const bf16_t* Vg; size_t vstride; const float* cum; int pt, ql, td, nmaxq; unsigned long long selm; float minv; lptr impw; };
enum { M_FOX = 0, M_WIN = 1, M_SEL = 2, M_CMPA = 3, M_CMPB = 4 };

template <int MODE>
__device__ __forceinline__ void run_tiles(lptr lds, unsigned long long tilemask, const TP& P, const bf16x8 (&qf)[4], St& st, int tid, int lane) {
    const int r32 = lane & 31, hh = lane >> 5;
    const int pi = (r32 & 3) | (((r32 >> 3) & 1) << 2) | (((r32 >> 4) & 1) << 3) | (((r32 >> 2) & 1) << 4);
    const int koff = pi * KROW + 16 * hh, voff = r32 * KROW + 32 * hh;
    const int srow = tid >> 3, sch = tid & 7;
    const bf16_t* kg = P.Kg + (size_t)srow * P.kstride + sch * 8;
    const bf16_t* vg = P.Vg + (size_t)srow * P.vstride + sch * 8;
    const int soff = srow * KROW + sch * 16;
    unsigned long long rem = tilemask;
    int t = __builtin_ctzll(rem); rem &= rem - 1ull;
    int buf = 0;
    {
        const u32x4 kr = *(const u32x4*)(kg + (size_t)(64 * t) * P.kstride);
        const u32x4 vr = *(const u32x4*)(vg + 64 * t);
        float cr = 0.f; if (MODE == M_FOX && tid < 64) cr = P.cum[64 * t + tid];
        *(LAS u32x4*)(lds + L_K + soff) = kr; *(LAS u32x4*)(lds + L_V + soff) = vr;
        if (MODE == M_FOX && tid < 64) *(LAS float*)(lds + L_CK + tid * 4) = cr;
    }
    __syncthreads();
    for (;;) {
        const bool more = rem != 0ull;
        const int tn = more ? __builtin_ctzll(rem) : 0;
        rem &= rem - 1ull;
        u32x4 kr = (u32x4){0u, 0u, 0u, 0u}, vr = kr; float cr = 0.f;
        if (more) {
            kr = *(const u32x4*)(kg + (size_t)(64 * tn) * P.kstride);
            vr = *(const u32x4*)(vg + 64 * tn);
            if (MODE == M_FOX && tid < 64) cr = P.cum[64 * tn + tid];
        }
        {
            lptr kb = lds + L_K + buf * TILEB, vb = lds + L_V + buf * TILEB, ck = lds + L_CK + buf * 256;
            f32x16 s0, s1;
            if (MODE == M_FOX) {
                if (t <= P.td) {
                    tile_qk<true>(s0, s1, kb, ck, qf, koff, hh);
                    if (t == P.td) tile_mask(s0, s1, P.ql, -1, hh);
                    tile_softmax_pv(s0, s1, st, vb, voff);
                }
            } else if (MODE == M_WIN) {
                tile_qk<false>(s0, s1, kb, ck, qf, koff, hh);
                if (t == P.pt) tile_mask(s0, s1, P.ql, -1, hh);
                else if (t == P.pt - 8) tile_mask(s0, s1, 63, P.ql, hh);
                tile_softmax_pv(s0, s1, st, vb, voff);
            } else if (MODE == M_SEL) {
                const int bit = (int)((P.selm >> t) & 1ull);
                if (__any(bit)) {
                    tile_qk<false>(s0, s1, kb, ck, qf, koff, hh);
                    const int thr = bit ? ((t == P.pt) ? P.ql : 63) : -1;
                    if (__any(thr != 63)) tile_mask(s0, s1, thr, -1, hh);
                    tile_softmax_pv(s0, s1, st, vb, voff);
                }
            } else if (MODE == M_CMPA) {
                int thr = P.nmaxq - 64 * t; thr = thr < -1 ? -1 : (thr > 63 ? 63 : thr);
                tile_qk<false>(s0, s1, kb, ck, qf, koff, hh);
                tile_mask(s0, s1, thr, -1, hh);
                tile_softmax_pv(s0, s1, st, vb, voff);
            } else {
                int thr = P.nmaxq - 64 * t; thr = thr < -1 ? -1 : (thr > 63 ? 63 : thr);
                tile_qk<false>(s0, s1, kb, ck, qf, koff, hh);
                tile_imp(s0, s1, st.m, P.minv, thr, t, P.impw, r32, hh);
            }
        }
        if (more) {
            const int nb = buf ^ 1;
            *(LAS u32x4*)(lds + L_K + nb * TILEB + soff) = kr; *(LAS u32x4*)(lds + L_V + nb * TILEB + soff) = vr;
            if (MODE == M_FOX && tid < 64) *(LAS float*)(lds + L_CK + nb * 256 + tid * 4) = cr;
        }
        __syncthreads();
        if (!more) break;
        t = tn; buf ^= 1;
    }
}

__device__ __forceinline__ void load_q(bf16x8 (&qf)[4], const bf16_t* qrow, int hh) {
#pragma unroll
    for (int d0 = 0; d0 < 4; ++d0) qf[d0] = *(const bf16x8*)(qrow + d0 * 16 + hh * 8);
}
__device__ __forceinline__ void store_o(bf16_t* op, const f32x16& a0, const f32x16& a1, int hh) {
#pragma unroll
    for (int g = 0; g < 4; ++g) {
        u32x2 w0, w1;
        w0.x = cvtpk(a0[4 * g], a0[4 * g + 1]); w0.y = cvtpk(a0[4 * g + 2], a0[4 * g + 3]);
        w1.x = cvtpk(a1[4 * g], a1[4 * g + 1]); w1.y = cvtpk(a1[4 * g + 2], a1[4 * g + 3]);
        *(u32x2*)(op + 8 * g + 4 * hh) = w0; *(u32x2*)(op + 32 + 8 * g + 4 * hh) = w1;
    }
}


__device__ __forceinline__ void accl_set(lptr aw, const f32x16& o0, const f32x16& o1, float sc, int r32, int hh) {
#pragma unroll
    for (int g = 0; g < 4; ++g) {
        const f32x4 a = (f32x4){o0[4 * g], o0[4 * g + 1], o0[4 * g + 2], o0[4 * g + 3]} * sc;
        const f32x4 b = (f32x4){o1[4 * g], o1[4 * g + 1], o1[4 * g + 2], o1[4 * g + 3]} * sc;
        *(LAS f32x4*)(aw + ((2 * g + hh) * 32 + r32) * 16) = a;
        *(LAS f32x4*)(aw + ((8 + 2 * g + hh) * 32 + r32) * 16) = b;
    }
}
__device__ __forceinline__ void accl_add(lptr aw, const f32x16& o0, const f32x16& o1, float sc, int r32, int hh) {
#pragma unroll
    for (int g = 0; g < 4; ++g) {
        const f32x4 a = (f32x4){o0[4 * g], o0[4 * g + 1], o0[4 * g + 2], o0[4 * g + 3]} * sc;
        const f32x4 b = (f32x4){o1[4 * g], o1[4 * g + 1], o1[4 * g + 2], o1[4 * g + 3]} * sc;
        LAS f32x4* pa = (LAS f32x4*)(aw + ((2 * g + hh) * 32 + r32) * 16);
        LAS f32x4* pb = (LAS f32x4*)(aw + ((8 + 2 * g + hh) * 32 + r32) * 16);
        *pa = *pa + a; *pb = *pb + b;
    }
}
__device__ __forceinline__ void accl_final_store(lptr aw, bf16_t* op, const f32x16& o0, const f32x16& o1, float sc, int r32, int hh) {
#pragma unroll
    for (int g = 0; g < 4; ++g) {
        const f32x4 a = (f32x4){o0[4 * g], o0[4 * g + 1], o0[4 * g + 2], o0[4 * g + 3]} * sc + *(const LAS f32x4*)(aw + ((2 * g + hh) * 32 + r32) * 16);
        const f32x4 b = (f32x4){o1[4 * g], o1[4 * g + 1], o1[4 * g + 2], o1[4 * g + 3]} * sc + *(const LAS f32x4*)(aw + ((8 + 2 * g + hh) * 32 + r32) * 16);
        u32x2 w0, w1;
        w0.x = cvtpk(a[0], a[1]); w0.y = cvtpk(a[2], a[3]); w1.x = cvtpk(b[0], b[1]); w1.y = cvtpk(b[2], b[3]);
        *(u32x2*)(op + 8 * g + 4 * hh) = w0; *(u32x2*)(op + 32 + 8 * g + 4 * hh) = w1;
    }
}

struct Bufs { const bf16_t *QN, *QR, *FQ, *FK, *KS, *KW, *VT, *KCC, *VCCT; const float *GATES, *CUM; bf16_t* MIXB; };

__device__ __forceinline__ void fox_unit(lptr lds, const Bufs& B, int b, int h, int qb, int tid, int lane, int w) {
    const int r32 = lane & 31, hh = lane >> 5;
    const int row = 256 * qb + 32 * w + r32; const size_t tok = (size_t)b * SEQ + row;
    bf16x8 qf[4]; load_q(qf, B.FQ + tok * 512 + h * 64, hh);
    TP P{}; P.Kg = B.FK + (size_t)b * SEQ * 512 + h * 64; P.kstride = 512; P.Vg = B.VT + (size_t)(256 + h * 64) * T_TOK + (size_t)b * SEQ; P.vstride = T_TOK;
    P.cum = B.CUM + (size_t)(b * 8 + h) * SEQ; P.td = 4 * qb + (w >> 1); P.ql = 32 * (w & 1) + r32; P.pt = 0; P.nmaxq = 0; P.selm = 0ull; P.minv = 0.f; P.impw = lds;
    const int ntile = 4 * qb + 4;
    const unsigned long long tm = ntile >= 64 ? ~0ull : ((1ull << ntile) - 1ull);
    St st; st_init(st);
    run_tiles<M_FOX>(lds, tm, P, qf, st, tid, lane);
    const float lt = hsum(st.l), inv = lt > 0.f ? 1.f / lt : 0.f;
    st.o0 *= inv; st.o1 *= inv;
    store_o(B.MIXB + tok * 1024 + 512 + h * 64, st.o0, st.o1, hh);
}

__device__ __forceinline__ void nsa_unit(lptr lds, const Bufs& B, int b, int g, int pt, int tid, int lane, int w) {
    const int r32 = lane & 31, hh = lane >> 5;
    const int hq = 4 * g + (w & 3), psub = w >> 2, ql = 32 * psub + r32, qpos = 64 * pt + ql;
    const size_t tok = (size_t)b * SEQ + qpos;
    const float* gp = B.GATES + tok * 24 + hq * 3;
    const float g_cmp = gp[0], g_sel = gp[1], g_win = gp[2];
    bf16x8 qf[4];
    TP P{}; P.pt = pt; P.ql = ql; P.td = 0; P.cum = nullptr; P.selm = 0ull; P.minv = 0.f;
    P.impw = lds + L_IMP + w * 8192;
    {
        load_q(qf, B.QN + tok * 512 + hq * 64, hh);
        P.Kg = B.KCC + (size_t)(b * 2 + g) * 256 * 64; P.kstride = 64; P.Vg = B.VCCT + (size_t)(b * 2 + g) * 64 * 256; P.vstride = 256;
        P.nmaxq = (qpos - 31) >> 4;
        const int ntc = (4 * pt + 2) / 64 + 1;
        const unsigned long long tm = (1ull << ntc) - 1ull;
        St st; st_init(st);
        run_tiles<M_CMPA>(lds, tm, P, qf, st, tid, lane);
        const float lt = hsum(st.l), inv = lt > 0.f ? 1.f / lt : 0.f;
        const float sc = inv * g_cmp;
        f32x16 c0 = st.o0 * sc, c1 = st.o1 * sc;
        if (pt >= 16) {
            LAS f32x4* z = (LAS f32x4*)(P.impw);
#pragma unroll
            for (int i = 0; i < 8; ++i) z[i * 64 + lane] = (f32x4){0.f, 0.f, 0.f, 0.f};
            asm volatile("s_waitcnt lgkmcnt(0)" ::: "memory");
            P.minv = inv;
            run_tiles<M_CMPB>(lds, tm, P, qf, st, tid, lane);
#pragma unroll 1
            for (int i = 0; i < 8; ++i) {
                const int p = w * 8 + i;
                float v = 0.f;
#pragma unroll
                for (int h4 = 0; h4 < 4; ++h4) v += *(const LAS float*)(lds + L_IMP + ((p >> 5) * 4 + h4) * 8192 + ((p & 31) * 64 + lane) * 4);
                const bool elig = lane >= 1 && lane <= pt - 2;
                const float vv = elig ? v : -1.f;
                LAS float* trow = (LAS float*)(lds + L_TOPK + w * 256);
                trow[lane] = vv;
                asm volatile("s_waitcnt lgkmcnt(0)" ::: "memory");
                int rank = 0;
#pragma unroll 4
                for (int c = 0; c < 16; ++c) {
                    const f32x4 o = *(const LAS f32x4*)(trow + 4 * c);
#pragma unroll
                    for (int e = 0; e < 4; ++e) rank += (o[e] > vv || (o[e] == vv && (4 * c + e) < lane)) ? 1 : 0;
                }
                asm volatile("s_waitcnt lgkmcnt(0)" ::: "memory");
                const bool sel = elig && rank < 13;
                const unsigned long long mk = __ballot(sel) | 1ull | (1ull << pt) | (1ull << (pt - 1));
                if (lane == 0) *(LAS unsigned long long*)(lds + L_SELM + p * 8) = mk;
            }
        } else {
            if (tid < 64) *(LAS unsigned long long*)(lds + L_SELM + tid * 8) = (2ull << pt) - 1ull;
        }
        __syncthreads();
        accl_set(P.impw, c0, c1, 1.f, r32, hh);
    }
    unsigned long long um;
    {
        const unsigned long long mine = *(const LAS unsigned long long*)(lds + L_SELM + lane * 8);
        unsigned lo = (unsigned)mine, hi = (unsigned)(mine >> 32);
#pragma unroll
        for (int o = 1; o < 64; o <<= 1) { lo |= __shfl_xor(lo, o); hi |= __shfl_xor(hi, o); }
        um = ((unsigned long long)hi << 32) | lo;
        P.selm = *(const LAS unsigned long long*)(lds + L_SELM + ql * 8);
    }
    load_q(qf, B.QR + tok * 512 + hq * 64, hh);
    {
        P.Kg = B.KW + (size_t)b * SEQ * 128 + g * 64; P.kstride = 128; P.Vg = B.VT + (size_t)(128 + g * 64) * T_TOK + (size_t)b * SEQ; P.vstride = T_TOK;
        const int t0 = pt >= 8 ? pt - 8 : 0;
        const unsigned long long tm = ((2ull << pt) - 1ull) & ~((1ull << t0) - 1ull);
        St st; st_init(st);
        run_tiles<M_WIN>(lds, tm, P, qf, st, tid, lane);
        const float lt = hsum(st.l), inv = lt > 0.f ? 1.f / lt : 0.f;
        accl_add(P.impw, st.o0, st.o1, inv * g_win, r32, hh);
    }
    {
        P.Kg = B.KS + (size_t)b * SEQ * 128 + g * 64; P.kstride = 128; P.Vg = B.VT + (size_t)(g * 64) * T_TOK + (size_t)b * SEQ; P.vstride = T_TOK;
        const unsigned long long tm = um & ((2ull << pt) - 1ull);
        St st; st_init(st);
        run_tiles<M_SEL>(lds, tm, P, qf, st, tid, lane);
        const float lt = hsum(st.l), inv = lt > 0.f ? 1.f / lt : 0.f;
        accl_final_store(P.impw, B.MIXB + tok * 1024 + hq * 64, st.o0, st.o1, inv * g_sel, r32, hh);
    }
}

struct UnitOrder { unsigned short u[2048]; };
constexpr UnitOrder make_order() {
    UnitOrder o{}; int fi = 0, ni = 0;
    for (int k = 0; k < 2048; ++k) {
        const int fcost = fi < 1024 ? 4 * (15 - fi / 64) + 4 : -1;
        const int ncost = ni < 1024 ? (63 - ni / 16) + 18 : -1;
        if (fcost >= ncost) { const int qb = 15 - fi / 64, bh = fi % 64; o.u[k] = (unsigned short)((qb << 6) | bh); ++fi; }
        else { const int pt = 63 - ni / 16, bg = ni % 16; o.u[k] = (unsigned short)(0x8000 | (pt << 4) | bg); ++ni; }
    }
    return o;
}
__device__ const UnitOrder g_order = make_order();

__device__ __forceinline__ void attention_phase(lptr lds, const Bufs& B, unsigned* ctr, int tid, int lane, int w) {
    for (;;) {
        if (tid == 0) *(LAS unsigned*)(lds + L_UNIT) = atomicAdd(ctr, 1u);
        __syncthreads();
        const unsigned k = *(const LAS unsigned*)(lds + L_UNIT);
        __syncthreads();
        if (k >= 2048u) break;
        const unsigned code = g_order.u[k];
        if (code & 0x8000u) nsa_unit(lds, B, (int)(code & 15u) >> 1, (int)(code & 1u), (int)((code >> 4) & 63u), tid, lane, w);
        else fox_unit(lds, B, (int)(code & 63u) >> 3, (int)(code & 7u), (int)((code >> 6) & 15u), tid, lane, w);
    }
}
}

__device__ __forceinline__ unsigned f2bf(float f) { unsigned u = __builtin_bit_cast(unsigned, f); return (u + 0x7fffu + ((u >> 16) & 1u)) >> 16; }
__device__ __forceinline__ unsigned pk2(float lo, float hi) { return f2bf(lo) | (f2bf(hi) << 16); }
__device__ __forceinline__ float wave_sum(float v) {
#pragma unroll
    for (int o = 1; o < 64; o <<= 1) v += __shfl_xor(v, o);
    return v;
}
__device__ __forceinline__ void tr_item(const float* W, int ldw, int srccol, int ncols, bf16_t* WT, int dstrow, int K, LAS float* scr, int item, int lane) {
    const int nblk = (ncols + 31) >> 5, kb = item / nblk, nb = item % nblk, k0 = 64 * kb, n0 = 32 * nb;
    const int nvalid = (ncols - n0) < 32 ? (ncols - n0) : 32;
    const int cl = lane & 31;
#pragma unroll 8
    for (int i = 0; i < 32; ++i) { const int kk = 2 * i + (lane >> 5); scr[kk * 33 + cl] = (cl < nvalid) ? W[(size_t)(k0 + kk) * ldw + srccol + n0 + cl] : 0.f; }
    asm volatile("s_waitcnt lgkmcnt(0)" ::: "memory");
    const int c = lane & 7;
#pragma unroll
    for (int j = 0; j < 4; ++j) {
        const int n = (lane >> 3) + 8 * j; const LAS float* s = scr + (8 * c) * 33 + n;
        u32x4 o; o.x = pk2(s[0 * 33], s[1 * 33]); o.y = pk2(s[2 * 33], s[3 * 33]); o.z = pk2(s[4 * 33], s[5 * 33]); o.w = pk2(s[6 * 33], s[7 * 33]);
        if (n < nvalid) *(u32x4*)(WT + (size_t)(dstrow + n0 + n) * K + k0 + 8 * c) = o;
    }
    asm volatile("s_waitcnt lgkmcnt(0)" ::: "memory");
}
__device__ __forceinline__ void norm_rows(const float* xin, const float* Y, const float* gpost, float* xout, bf16_t* HB, const float* gpre, int gw, int ngw, int lane) {
    for (int row = gw; row < T_TOK; row += ngw) {
        const f32x4* xr = (const f32x4*)(xin + (size_t)row * DM) + lane;
        f32x4 v[4];
#pragma unroll
        for (int j = 0; j < 4; ++j) v[j] = xr[64 * j];
        if (Y) {
            const f32x4* yr = (const f32x4*)(Y + (size_t)row * DM) + lane;
            f32x4 y[4]; float s = 0.f;
#pragma unroll
            for (int j = 0; j < 4; ++j) { y[j] = yr[64 * j]; s += (y[j].x * y[j].x + y[j].y * y[j].y) + (y[j].z * y[j].z + y[j].w * y[j].w); }
            const float rstd = 1.0f / sqrtf(wave_sum(s) * (1.f / DM) + NORM_EPS);
#pragma unroll
            for (int j = 0; j < 4; ++j) { const f32x4 gg = *((const f32x4*)gpost + 64 * j + lane); v[j] += y[j] * rstd * gg; }
        }
        if (xout) {
            f32x4* xo = (f32x4*)(xout + (size_t)row * DM) + lane;
#pragma unroll
            for (int j = 0; j < 4; ++j) xo[64 * j] = v[j];
        }
        if (HB) {
            float s = 0.f;
#pragma unroll
            for (int j = 0; j < 4; ++j) s += (v[j].x * v[j].x + v[j].y * v[j].y) + (v[j].z * v[j].z + v[j].w * v[j].w);
            const float rstd = 1.0f / sqrtf(wave_sum(s) * (1.f / DM) + NORM_EPS);
            u32x2* ho = (u32x2*)(HB + (size_t)row * DM) + lane;
#pragma unroll
            for (int j = 0; j < 4; ++j) { const f32x4 gg = *((const f32x4*)gpre + 64 * j + lane); const f32x4 o = v[j] * rstd * gg; u32x2 w; w.x = pk2(o.x, o.y); w.y = pk2(o.z, o.w); ho[64 * j] = w; }
        }
    }
}

struct Args { const float* in[21]; float* out; unsigned char* ws; };
enum { I_X = 0, I_WIN, I_BGATE, I_BFORGET, I_POSK, I_W1K, I_B1K, I_W2K, I_B2K, I_POSV, I_W1V, I_B1V, I_W2V, I_B2V, I_WOUT, I_WUP, I_WDN, I_GPREMIX, I_GPOSTMIX, I_GPREMLP, I_GPOSTMLP };


#define CAS __attribute__((address_space(4)))
__device__ __forceinline__ const float* argp(int i) {
    const CAS char* kp = (const CAS char*)__builtin_amdgcn_kernarg_segment_ptr();
    asm volatile("" : "+s"(kp));
    return *(const float* const CAS*)(kp + 8 * i);
}
#define ARG(i) argp(i)
#define PHASE_PTRS() int tid = threadIdx.x; asm volatile("" : "+v"(tid)); const int lane = tid & 63, wave = __builtin_amdgcn_readfirstlane(tid >> 6); const int G = gridDim.x, bx = blockIdx.x; const int gw = bx * 8 + wave, NGW = G * 8; (void)lane; (void)gw; (void)NGW; \
    unsigned char* ws = (unsigned char*)argp(22); float* X = (float*)argp(21); (void)X; \
    bf16_t* WA = (bf16_t*)(ws + WS_WA); bf16_t* WB = (bf16_t*)(ws + WS_WB); bf16_t* WO = (bf16_t*)(ws + WS_WO); bf16_t* WUP = (bf16_t*)(ws + WS_WUP); bf16_t* WDN = (bf16_t*)(ws + WS_WDN); \
    bf16_t* W1K = (bf16_t*)(ws + WS_W1K); bf16_t* W1V = (bf16_t*)(ws + WS_W1V); bf16_t* W2K = (bf16_t*)(ws + WS_W2K); bf16_t* W2V = (bf16_t*)(ws + WS_W2V); \
    float* C1 = (float*)(ws + WS_C1); float* ROPE = (float*)(ws + WS_ROPE); \
    bf16_t* HB = (bf16_t*)(ws + WS_HB); float* Y = (float*)(ws + WS_Y); \
    bf16_t* QN = (bf16_t*)(ws + WS_QN); bf16_t* QR = (bf16_t*)(ws + WS_QR); bf16_t* FQ = (bf16_t*)(ws + WS_FQ); bf16_t* FK = (bf16_t*)(ws + WS_FK); \
    bf16_t* KS = (bf16_t*)(ws + WS_KS); bf16_t* KW = (bf16_t*)(ws + WS_KW); bf16_t* KC = (bf16_t*)(ws + WS_KC); bf16_t* VC = (bf16_t*)(ws + WS_VC); bf16_t* VT = (bf16_t*)(ws + WS_VT); \
    bf16_t* U = (bf16_t*)(ws + WS_U); \
    float* GATES = (float*)(ws + WS_GATES); float* LOGF = (float*)(ws + WS_LOGF); float* CUM = (float*)(ws + WS_CUM); \
    bf16_t* KCC = (bf16_t*)(ws + WS_KCC); bf16_t* VCCT = (bf16_t*)(ws + WS_VCCT); bf16_t* HIDK = (bf16_t*)(ws + WS_HIDK); bf16_t* HIDV = (bf16_t*)(ws + WS_HIDV); \
    unsigned* ctl = (unsigned*)(ws + WS_CTL); \
    (void)WA; (void)WB; (void)WO; (void)WUP; (void)WDN; (void)W1K; (void)W1V; (void)W2K; (void)W2V; (void)C1; (void)ROPE; (void)HB; (void)Y; (void)QN; (void)QR; (void)FQ; (void)FK; (void)KS; (void)KW; (void)KC; (void)VC; (void)VT; (void)U; (void)GATES; (void)LOGF; (void)CUM; (void)KCC; (void)VCCT; (void)HIDK; (void)HIDV; (void)ctl

__global__ void __launch_bounds__(512, 2) mega_fwd(Args a) {
    extern __shared__ __attribute__((aligned(16))) unsigned char lds_raw[];
    lptr lds = (lptr)lds_raw;
    cg::grid_group grid = cg::this_grid();

    {
        unsigned char* ws0 = (unsigned char*)argp(22);
        float* ROPE0 = (float*)(ws0 + WS_ROPE);
        const int gt = blockIdx.x * 512 + threadIdx.x;
        if (gt < 4096 * 8) {
            const int pos = gt >> 3, i = gt & 7;
            const float inv = powf(500000.f, -(float)i * 0.125f);
            const float ang = (float)pos * inv;
            ROPE0[gt * 2] = (float)cos((double)ang); ROPE0[gt * 2 + 1] = (float)sin((double)ang);
        }
    }
#pragma unroll 1
    for (int l = 0; l < NLAYER; ++l) {
        {
            PHASE_PTRS();
            const float* w_in = ARG(I_WIN) + (size_t)l * DM * WIN_COLS;
            const float* w_out = ARG(I_WOUT) + (size_t)l * DM * DM;
            const float* w_up = ARG(I_WUP) + (size_t)l * DM * DFF;
            const float* w_dn = ARG(I_WDN) + (size_t)l * DFF * DM;
            const float* w1k = ARG(I_W1K) + (size_t)l * 2048 * 256; const float* w1v = ARG(I_W1V) + (size_t)l * 2048 * 256;
            const float* w2k = ARG(I_W2K) + (size_t)l * 256 * 64; const float* w2v = ARG(I_W2V) + (size_t)l * 256 * 64;
            LAS float* scr = (LAS float*)(lds + wave * 8704);
            constexpr int NIT_IN = 16 * (16 + 4 + 4 + 4 + 4 + 16 + 16 + 1 + 1 + 4 + 4 + 16);
            constexpr int NITEMS = NIT_IN + 16 * 32 + 16 * 128 + 64 * 32 + 2 * 32 * 8 + 2 * 4 * 2;
            for (int it = gw; it < NITEMS; it += NGW) {
                int r = it;
#define SEG(Wp, ldw, srccol, ncols, WTp, dstrow, KK) { const int n_ = (((ncols) + 31) / 32) * ((KK) / 64); if (r < n_) { tr_item(Wp, ldw, srccol, ncols, WTp, dstrow, KK, scr, r, lane); continue; } r -= n_; }
                SEG(w_in, WIN_COLS, 0, 512, WA, 0, DM)
                SEG(w_in, WIN_COLS, 512, 128, WA, 512, DM)
                SEG(w_in, WIN_COLS, 640, 128, WA, 640, DM)
                SEG(w_in, WIN_COLS, 768, 128, WA, 768, DM)
                SEG(w_in, WIN_COLS, 1024, 128, WA, 896, DM)
                SEG(w_in, WIN_COLS, 1304, 512, WA, 1024, DM)
                SEG(w_in, WIN_COLS, 1816, 512, WA, 1536, DM)
                SEG(w_in, WIN_COLS, 1280, 24, WA, 2048, DM)
                SEG(w_in, WIN_COLS, 2840, 8, WA, 2072, DM)
                SEG(w_in, WIN_COLS, 896, 128, WB, 0, DM)
                SEG(w_in, WIN_COLS, 1152, 128, WB, 128, DM)
                SEG(w_in, WIN_COLS, 2328, 512, WB, 256, DM)
                SEG(w_out, DM, 0, DM, WO, 0, DM)
                SEG(w_up, DFF, 0, DFF, WUP, 0, DM)
                SEG(w_dn, DM, 0, DM, WDN, 0, DFF)
                SEG(w1k, 256, 0, 256, W1K, 0, 2048)
                SEG(w1v, 256, 0, 256, W1V, 0, 2048)
                SEG(w2k, 64, 0, 64, W2K, 0, 256)
                SEG(w2v, 64, 0, 64, W2V, 0, 256)
#undef SEG
            }
            {
                const int gt = bx * 512 + tid, ngt = G * 512;
                const u32x4 z = (u32x4){0u, 0u, 0u, 0u};
                for (int i = gt; i < 224 * 1024 / 8; i += ngt) *((u32x4*)(WA + (size_t)2080 * DM) + i) = z;
                for (int i = gt; i < 192 * 256 / 8; i += ngt) { *((u32x4*)(W2K + 64 * 256) + i) = z; *((u32x4*)(W2V + 64 * 256) + i) = z; }
            }
            for (int it = bx; it < 8; it += G) {
                const int kv = it >> 2, jb = it & 3, kc = tid >> 6, j = jb * 64 + (tid & 63);
                const float* pos = (kv ? ARG(I_POSV) : ARG(I_POSK)) + (size_t)l * 2048;
                const float* w1 = kv ? w1v : w1k;
                const float* b1 = (kv ? ARG(I_B1V) : ARG(I_B1K)) + (size_t)l * 256;
                float s = 0.f;
#pragma unroll 8
                for (int k = 256 * kc; k < 256 * kc + 256; ++k) s += pos[k] * w1[(size_t)k * 256 + j];
                LAS float* red = (LAS float*)(lds + 81920);
                red[tid] = s;
                __syncthreads();
                if (tid < 64) { float tot = b1[j]; for (int q = 0; q < 8; ++q) tot += red[q * 64 + tid]; C1[kv * 256 + j] = tot; }
                __syncthreads();
            }
            if (l == 0) norm_rows(ARG(I_X), nullptr, nullptr, X, HB, ARG(I_GPREMIX), gw, NGW, lane);
            else norm_rows(X, Y, ARG(I_GPOSTMLP) + (size_t)(l - 1) * DM, X, HB, ARG(I_GPREMIX) + (size_t)l * DM, gw, NGW, lane);
        }
        grid.sync();
        {
            PHASE_PTRS();
            pg8::Gemm g{HB, WA, T_TOK, NA, DM, DM}; pg8::StaticOrder S; S.init(T_TOK, NA, G, bx);
            pg8::EpiIn E{ws, ARG(I_BGATE) + l * 24, ARG(I_BFORGET) + l * 8};
            pg8::gemm_phase<pg8::EpiIn, pg8::StaticOrder, true, true>(lds, g, S, E);
            pg8::Gemm g2{WB, HB, NB, T_TOK, DM, DM}; pg8::StaticOrder S2; S2.init(NB, T_TOK, G, bx);
            pg8::EpiStoreBf16<0> E2{VT, (size_t)T_TOK, nullptr};
            pg8::gemm_phase<pg8::EpiStoreBf16<0>, pg8::StaticOrder, true, true>(lds, g2, S2, E2);
        }
        grid.sync();
        {
            PHASE_PTRS();
            pg8::Gemm gk{KC, W1K, 4096, 256, 2048, 1024}; pg8::RangeOrder Sk; Sk.init(4096, 256, G, bx, 0);
            pg8::EpiStoreBf16<2> Ek{HIDK, 256, C1};
            pg8::gemm_phase<pg8::EpiStoreBf16<2>, pg8::RangeOrder, false, true>(lds, gk, Sk, Ek);
            pg8::Gemm gv{VC, W1V, 4096, 256, 2048, 1024}; pg8::RangeOrder Sv; Sv.init(4096, 256, G, bx, 16 % G);
            pg8::EpiStoreBf16<2> Ev{HIDV, 256, C1 + 256};
            pg8::gemm_phase<pg8::EpiStoreBf16<2>, pg8::RangeOrder, false, true>(lds, gv, Sv, Ev);
            if (wave == 0) {
                for (int task = ((bx - 32) % G + G) % G; task < 64; task += G) {
                    const int b = task >> 3, h = task & 7;
                    const float* lf = LOGF + ((size_t)b * SEQ + 64 * lane) * 8 + h;
                    double s = 0.0;
                    for (int i = 0; i < 64; ++i) s += (double)lf[i * 8];
                    double pre = s;
#pragma unroll
                    for (int o = 1; o < 64; o <<= 1) { const double up = __shfl_up(pre, o); if (lane >= o) pre += up; }
                    double run = pre - s;
                    float* co = CUM + (size_t)task * SEQ + 64 * lane;
                    for (int i = 0; i < 64; ++i) { run += (double)lf[i * 8]; co[i] = (float)run * LOG2E; }
                }
            }
        }
        grid.sync();
        {
            PHASE_PTRS();
            pg8::Gemm gk{HIDK, W2K, 4096, 256, 256, 256}; pg8::RangeOrder Sk; Sk.init(4096, 256, G, bx, 0);
            pg8::EpiCmp2 Ek{KCC, ARG(I_B2K) + l * 64, 0};
            pg8::gemm_phase<pg8::EpiCmp2, pg8::RangeOrder, false, true>(lds, gk, Sk, Ek);
            pg8::Gemm gv{HIDV, W2V, 4096, 256, 256, 256}; pg8::RangeOrder Sv; Sv.init(4096, 256, G, bx, 16 % G);
            pg8::EpiCmp2 Ev{VCCT, ARG(I_B2V) + l * 64, 1};
            pg8::gemm_phase<pg8::EpiCmp2, pg8::RangeOrder, false, true>(lds, gv, Sv, Ev);
        }
        grid.sync();
        {
            PHASE_PTRS();
            att::Bufs B{QN, QR, FQ, FK, KS, KW, VT, KCC, VCCT, GATES, CUM, HB};
            att::attention_phase(lds, B, ctl + 64 * l, tid, lane, wave);
        }
        grid.sync();
        {
            PHASE_PTRS();
            pg8::Gemm g{HB, WO, T_TOK, DM, DM, DM}; pg8::StaticOrder S; S.init(T_TOK, DM, G, bx);
            pg8::EpiStoreF32 E{Y, (size_t)DM};
            pg8::gemm_phase<pg8::EpiStoreF32, pg8::StaticOrder, true, true>(lds, g, S, E);
        }
        grid.sync();
        { PHASE_PTRS(); norm_rows(X, Y, ARG(I_GPOSTMIX) + (size_t)l * DM, X, HB, ARG(I_GPREMLP) + (size_t)l * DM, gw, NGW, lane); }
        grid.sync();
        {
            PHASE_PTRS();
            pg8::Gemm g{HB, WUP, T_TOK, DFF, DM, DM}; pg8::StaticOrder S; S.init(T_TOK, DFF, G, bx);
            pg8::EpiStoreBf16<1> E{U, (size_t)DFF, nullptr};
            pg8::gemm_phase<pg8::EpiStoreBf16<1>, pg8::StaticOrder, true, true>(lds, g, S, E);
        }
        grid.sync();
        {
            PHASE_PTRS();
            pg8::Gemm g{U, WDN, T_TOK, DM, DFF, DFF}; pg8::StaticOrder S; S.init(T_TOK, DM, G, bx);
            pg8::EpiStoreF32 E{Y, (size_t)DM};
            pg8::gemm_phase<pg8::EpiStoreF32, pg8::StaticOrder, true, true>(lds, g, S, E);
        }
        grid.sync();
    }
    { PHASE_PTRS(); norm_rows(X, Y, ARG(I_GPOSTMLP) + (size_t)(NLAYER - 1) * DM, X, nullptr, nullptr, gw, NGW, lane); }
}

extern "C" void kernel_launch(void* const* d_in, const int* in_sizes, int n_in, void* d_out, int out_size, void* d_ws, size_t ws_size, hipStream_t stream) {
    static int grid = 0;
    if (grid == 0) {
        if (n_in != 21 || out_size != T_TOK * DM || ws_size < WS_END) { fprintf(stderr, "kernel_launch: unexpected shapes (n_in %d out %d ws %zu)\n", n_in, out_size, ws_size); grid = -1; return; }
        int dev = 0, cus = 0, per_cu = 0;
        hipGetDevice(&dev);
        hipDeviceGetAttribute(&cus, hipDeviceAttributeMultiprocessorCount, dev);
        if (hipFuncSetAttribute((const void*)mega_fwd, hipFuncAttributeMaxDynamicSharedMemorySize, LDS_BYTES) != hipSuccess) { fprintf(stderr, "kernel_launch: hipFuncSetAttribute failed\n"); grid = -1; return; }
        if (hipOccupancyMaxActiveBlocksPerMultiprocessor(&per_cu, (const void*)mega_fwd, 512, LDS_BYTES) != hipSuccess || per_cu < 1) { fprintf(stderr, "kernel_launch: occupancy query gives %d\n", per_cu); per_cu = 1; }
        (void)hipGetLastError();
        grid = cus * 1;
        if (grid < 64) grid = 64;
    }
    if (grid < 0) return;
    hipMemsetAsync((char*)d_ws + WS_CTL, 0, 4096, stream);
    Args a{};
    for (int i = 0; i < 21; ++i) a.in[i] = (const float*)d_in[i];
    a.out = (float*)d_out; a.ws = (unsigned char*)d_ws;
    void* args[] = {&a};
    hipError_t e = hipLaunchCooperativeKernel((const void*)mega_fwd, dim3(grid), dim3(512), args, LDS_BYTES, stream);
    if (e != hipSuccess) fprintf(stderr, "cooperative launch failed: %s (grid %d)\n", hipGetErrorString(e), grid);
}
```

```cpp
#include <hip/hip_runtime.h>
#include <hip/hip_cooperative_groups.h>
#include <cstdio>
#include <cstdint>
namespace cg = cooperative_groups;
namespace pg8 {
#define PG8_LAS __attribute__((address_space(3)))
typedef unsigned short bf16_t;
typedef short bf16x8 __attribute__((ext_vector_type(8)));
typedef float f32x4 __attribute__((ext_vector_type(4)));
typedef unsigned u32x4 __attribute__((ext_vector_type(4)));
constexpr int BM = 256, BK = 64, HALF = 128, HTB = HALF * BK * 2  , STAGE_BYTES = 8 * HTB, NXCD = 8, WGM = 8;

__host__ __device__ __forceinline__ int lds_byte(int r, int c) { const int st = (r >> 4) * 2 + (c >> 5), rr = r & 15, cc = c & 31, ob = rr * 64 + cc * 2; return st * 1024 + (ob ^ (((ob >> 9) & 1) << 5)); }
__host__ __device__ __forceinline__ void stage_rc(int b, int& R, int& C) { const int st = b / 1024, sb = b % 1024, swz = sb ^ (((sb >> 9) & 1) << 5); R = (st >> 1) * 16 + swz / 64; C = (st & 1) * 32 + (swz % 64) / 2; }
__host__ __device__ __forceinline__ int perm32(int rho) { const int n = rho >> 4, i = rho & 15; return 8 * (i >> 2) + 4 * n + (i & 3); }

struct Unit { int pm, pn; };
struct Gemm { const bf16_t* A; const bf16_t* Bt; int M, N, K, lda; };

struct StaticOrder {
    int nM, nN, nwg, G, c;
    __host__ __device__ void init(int M, int N, int G_, int c_) { nM = M / BM; nN = N / BM; nwg = nM * nN; G = G_; c = c_; }
    __host__ __device__ bool next(int i, Unit& u) const {
        const long L = (long)i * G + c; if (L >= nwg) return false;
        int wgid = (int)L; { const int q = nwg / NXCD, r = nwg % NXCD, xcd = wgid % NXCD, off = wgid / NXCD; wgid = (xcd < r ? xcd * (q + 1) : r * (q + 1) + (xcd - r) * q) + off; }
        const int nig = WGM * nN, gid = wgid / nig, fm = gid * WGM, gsz = (nM - fm) < WGM ? (nM - fm) : WGM;
        u.pm = fm + ((wgid % nig) % gsz); u.pn = (wgid % nig) / gsz; return true;
    }
    __device__ __forceinline__ void a_ready(const Unit&) const {}
    __device__ __forceinline__ void done(const Unit&) const {}
};

__device__ __forceinline__ unsigned cvt_pk_bf16(float lo, float hi) { unsigned r; asm volatile("v_cvt_pk_bf16_f32 %0, %1, %2" : "=v"(r) : "v"(lo), "v"(hi)); return r; }
template <class Epi, class Sched, bool ALIGN_EPI = false, bool SP2 = false>
__device__ __forceinline__ void gemm_phase(PG8_LAS unsigned char* lds, const Gemm g, const Sched& S, const Epi& E) {
    int tid_ = threadIdx.x; asm volatile("" : "+v"(tid_));
    const int tid = tid_, wid = __builtin_amdgcn_readfirstlane(tid >> 6), lane = tid & 63, wr = wid >> 2, wc = wid & 3, fr = lane & 15, fq = lane >> 4;
    const int K = g.K, nt = K / BK;
    unsigned voffA[2], voffB[2];
#pragma unroll
    for (int i = 0; i < 2; ++i) { int R, C; stage_rc(tid * 16 + i * 8192, R, C); const int Rb = Epi::PERM ? ((R & ~31) + perm32(R & 31)) : R;
        voffA[i] = (unsigned)(R * g.lda + C) * 2u; voffB[i] = (unsigned)(Rb * K + C) * 2u; }
    const size_t kstep = (size_t)(BK * 2);
    const size_t hstep = (size_t)HALF * K * 2;
    const size_t tstep = 2 * hstep; const size_t hstepA = (size_t)HALF * g.lda * 2, tstepA = 2 * hstepA;
    const unsigned ldsw = (unsigned)wid * 1024u;
    const int aoff = lds_byte(wr * 64 + fr, fq * 8), boff = lds_byte(wc * 32 + fr, fq * 8);
#define PG8_SA(b, h) (((b) * 2 + (h)) * HTB)
#define PG8_SB(b, h) ((4 + (b) * 2 + (h)) * HTB)
#define PG8_STAGE(bufoff, gbase, voff) do { _Pragma("unroll") for (int _i = 0; _i < 2; ++_i) \
        __builtin_amdgcn_global_load_lds((const unsigned*)((const char*)(gbase) + (voff)[_i]), (PG8_LAS unsigned*)(lds + (bufoff) + ldsw + _i * 8192), 16, 0, 0); } while (0)
#define PG8_LDA(dst, b, h) do { _Pragma("unroll") for (int m = 0; m < 4; ++m) _Pragma("unroll") for (int k = 0; k < 2; ++k) dst[m][k] = *(const PG8_LAS bf16x8*)(lds + PG8_SA(b, h) + aoff + m * 2048 + k * 1024); } while (0)
#define PG8_LDB(dst, b, h) do { _Pragma("unroll") for (int n = 0; n < 2; ++n) _Pragma("unroll") for (int k = 0; k < 2; ++k) dst[n][k] = *(const PG8_LAS bf16x8*)(lds + PG8_SB(b, h) + boff + n * 2048 + k * 1024); } while (0)
#define PG8_MMA(ai, bj, At, Bt) do { __builtin_amdgcn_s_setprio(1); _Pragma("unroll") for (int m = 0; m < 4; ++m) _Pragma("unroll") for (int n = 0; n < 2; ++n) _Pragma("unroll") for (int k = 0; k < 2; ++k) \
        acc[ai][bj][m][n] = __builtin_amdgcn_mfma_f32_16x16x32_bf16(Bt[n][k], At[m][k], acc[ai][bj][m][n], 0, 0, 0); __builtin_amdgcn_s_setprio(0); } while (0)
#define PG8_WAIT_V(n) asm volatile("s_waitcnt vmcnt(" #n ")" ::: "memory")
#define PG8_WAIT_L(n) asm volatile("s_waitcnt lgkmcnt(" #n ")" ::: "memory")
#define PG8_BAR __builtin_amdgcn_s_barrier()
#define PG8_SCHED __builtin_amdgcn_sched_barrier(0)
    Unit cur, nxt; int ui = 0;
    if (!S.next(0, cur)) return;
    f32x4 acc[2][2][4][2];
#pragma unroll
    for (int a = 0; a < 2; ++a)
#pragma unroll
        for (int b = 0; b < 2; ++b)
#pragma unroll
            for (int m = 0; m < 4; ++m)
#pragma unroll
                for (int n = 0; n < 2; ++n) acc[a][b][m][n] = (f32x4){0.f, 0.f, 0.f, 0.f};
    bf16x8 At[4][2], B0[2][2], B1[2][2];
    const char* cA = (const char*)g.A + (size_t)cur.pm * tstepA; const char* cB = (const char*)g.Bt + (size_t)cur.pn * tstep;
    S.a_ready(cur);
    if constexpr (SP2) {
        PG8_STAGE(PG8_SB(0, 0), cB, voffB); PG8_STAGE(PG8_SB(0, 1), cB + hstep, voffB); PG8_STAGE(PG8_SA(0, 0), cA, voffA); PG8_STAGE(PG8_SA(0, 1), cA + hstepA, voffA);
        if (wr == 1) PG8_BAR;
        PG8_WAIT_V(2); PG8_BAR;
        PG8_STAGE(PG8_SB(1, 0), cB + kstep, voffB); PG8_STAGE(PG8_SA(1, 0), cA + kstep, voffA); PG8_STAGE(PG8_SB(1, 1), cB + hstep + kstep, voffB);
        PG8_WAIT_V(6); PG8_BAR;
    } else {
        PG8_STAGE(PG8_SB(0, 0), cB, voffB); PG8_STAGE(PG8_SA(0, 0), cA, voffA); PG8_STAGE(PG8_SB(0, 1), cB + hstep, voffB); PG8_STAGE(PG8_SA(0, 1), cA + hstepA, voffA);
        if (wr == 1) PG8_BAR;
        PG8_WAIT_V(4); PG8_BAR;
        PG8_STAGE(PG8_SB(1, 0), cB + kstep, voffB); PG8_STAGE(PG8_SA(1, 0), cA + kstep, voffA); PG8_STAGE(PG8_SB(1, 1), cB + hstep + kstep, voffB);
        PG8_WAIT_V(6); PG8_BAR;
    }
    for (;;) {
        const bool has_next = S.next(ui + 1, nxt);
        const char* nA = has_next ? (const char*)g.A + (size_t)nxt.pm * tstepA : cA; const char* nB = has_next ? (const char*)g.Bt + (size_t)nxt.pn * tstep : cB;
        for (int t = 0; t < nt; t += 2) {
            const bool last = (t == nt - 2);
            const char* a1 = cA + (size_t)(t + 1) * kstep;
            const char* a2 = last ? nA : cA + (size_t)(t + 2) * kstep; const char* b2 = last ? nB : cB + (size_t)(t + 2) * kstep;
            const char* a3 = a2 + kstep; const char* b3 = b2 + kstep;
            if (last && has_next) S.a_ready(nxt);
            if constexpr (SP2) {
            PG8_LDB(B0, 0, 0); PG8_LDB(B1, 0, 1); PG8_SCHED; PG8_LDA(At, 0, 0); PG8_STAGE(PG8_SA(1, 1), a1 + hstepA, voffA);
            PG8_WAIT_V(8); PG8_WAIT_L(0); PG8_BAR; PG8_MMA(0, 0, At, B0); PG8_MMA(0, 1, At, B1); PG8_BAR; PG8_SCHED;
            PG8_LDA(At, 0, 1); PG8_STAGE(PG8_SB(0, 0), b2, voffB); PG8_STAGE(PG8_SB(0, 1), b2 + hstep, voffB); PG8_STAGE(PG8_SA(0, 0), a2, voffA);
            PG8_WAIT_V(8); PG8_WAIT_L(0); PG8_BAR; PG8_MMA(1, 0, At, B0); PG8_MMA(1, 1, At, B1); PG8_BAR; PG8_SCHED;
            PG8_LDB(B0, 1, 0); PG8_LDB(B1, 1, 1); PG8_SCHED; PG8_LDA(At, 1, 0); PG8_STAGE(PG8_SA(0, 1), a2 + hstepA, voffA);
            PG8_WAIT_V(8); PG8_WAIT_L(0); PG8_BAR; PG8_MMA(0, 0, At, B0); PG8_MMA(0, 1, At, B1); PG8_BAR; PG8_SCHED;
            PG8_LDA(At, 1, 1); PG8_STAGE(PG8_SB(1, 0), b3, voffB); PG8_STAGE(PG8_SB(1, 1), b3 + hstep, voffB); PG8_STAGE(PG8_SA(1, 0), a3, voffA);
            PG8_WAIT_V(8); PG8_WAIT_L(0); PG8_BAR; PG8_MMA(1, 0, At, B0); PG8_MMA(1, 1, At, B1); PG8_BAR; PG8_SCHED;
            } else {
            PG8_LDB(B0, 0, 0); PG8_SCHED; PG8_LDA(At, 0, 0); PG8_STAGE(PG8_SA(1, 1), a1 + hstepA, voffA);
            PG8_WAIT_L(8); PG8_BAR; PG8_WAIT_L(0); PG8_MMA(0, 0, At, B0); PG8_BAR; PG8_SCHED;
            PG8_LDB(B1, 0, 1); PG8_STAGE(PG8_SB(0, 0), b2, voffB);
            PG8_BAR; PG8_WAIT_L(0); PG8_MMA(0, 1, At, B1); PG8_BAR;
            PG8_LDA(At, 0, 1); PG8_STAGE(PG8_SA(0, 0), a2, voffA);
            PG8_BAR; PG8_WAIT_L(0); PG8_MMA(1, 0, At, B0); PG8_BAR; PG8_SCHED;
            PG8_STAGE(PG8_SB(0, 1), b2 + hstep, voffB);
            PG8_WAIT_V(6); PG8_BAR; PG8_MMA(1, 1, At, B1); PG8_BAR;
            PG8_LDB(B0, 1, 0); PG8_SCHED; PG8_LDA(At, 1, 0); PG8_STAGE(PG8_SA(0, 1), a2 + hstepA, voffA);
            PG8_WAIT_L(8); PG8_BAR; PG8_WAIT_L(0); PG8_MMA(0, 0, At, B0); PG8_BAR; PG8_SCHED;
            PG8_LDB(B1, 1, 1); PG8_STAGE(PG8_SB(1, 0), b3, voffB);
            PG8_BAR; PG8_WAIT_L(0); PG8_MMA(0, 1, At, B1); PG8_BAR;
            PG8_LDA(At, 1, 1); PG8_STAGE(PG8_SA(1, 0), a3, voffA);
            PG8_BAR; PG8_WAIT_L(0); PG8_MMA(1, 0, At, B0); PG8_BAR; PG8_SCHED;
            PG8_STAGE(PG8_SB(1, 1), b3 + hstep, voffB);
            PG8_WAIT_V(6); PG8_BAR; PG8_MMA(1, 1, At, B1); PG8_BAR;
            }
        }
        if constexpr (ALIGN_EPI) { if (wr == 0) PG8_BAR; }
        if constexpr (!Epi::AFTER_DRAIN) { E(acc, cur, wr, wc, fr, fq); S.done(cur); }
        if (!has_next) break;
#pragma unroll
        for (int a = 0; a < 2; ++a)
#pragma unroll
            for (int b = 0; b < 2; ++b)
#pragma unroll
                for (int m = 0; m < 4; ++m)
#pragma unroll
                    for (int n = 0; n < 2; ++n) acc[a][b][m][n] = (f32x4){0.f, 0.f, 0.f, 0.f};
        cur = nxt; cA = nA; cB = nB; ++ui;
        if constexpr (ALIGN_EPI) { if (wr == 1) PG8_BAR; }
    }
    PG8_WAIT_V(0);
    if constexpr (!ALIGN_EPI) { if (wr == 0) PG8_BAR; }
    PG8_BAR;
    if constexpr (Epi::AFTER_DRAIN) { E.fused(acc, cur, wr, wc, fr, fq, lds, wid, lane); S.done(cur); }
#undef PG8_SA
#undef PG8_SB
#undef PG8_STAGE
#undef PG8_LDA
#undef PG8_LDB
#undef PG8_MMA
#undef PG8_WAIT_V
#undef PG8_WAIT_L
#undef PG8_BAR
#undef PG8_SCHED
}
}

constexpr int T_TOK = 32768, SEQ = 4096, DM = 1024, NLAYER = 4, DFF = 4096;
constexpr int NA = 2304, NB = 768, WIN_COLS = 2848;
constexpr float LOG2E = 1.4426950408889634f;
constexpr float QSCALE = 0.125f * LOG2E;
constexpr float NORM_EPS = 1e-6f;
constexpr size_t MiB = 1u << 20;
constexpr size_t WS_CTL = 0;
constexpr size_t WS_WA = 1 * MiB, WS_WB = WS_WA + (size_t)NA * DM * 2, WS_WO = 7 * MiB, WS_WUP = 9 * MiB, WS_WDN = 17 * MiB;
constexpr size_t WS_W1K = 25 * MiB, WS_W1V = 26 * MiB, WS_W2K = 27 * MiB, WS_W2V = WS_W2K + 131072, WS_C1 = WS_W2V + 131072, WS_ROPE = 27 * MiB + 512 * 1024;
constexpr size_t WS_HB = 28 * MiB, WS_Y = 92 * MiB, WS_BIG = 220 * MiB;
constexpr size_t WS_QN = WS_BIG, WS_QR = WS_BIG + 32 * MiB, WS_FQ = WS_BIG + 64 * MiB, WS_FK = WS_BIG + 96 * MiB, WS_KS = WS_BIG + 128 * MiB, WS_KW = WS_BIG + 136 * MiB;
constexpr size_t WS_KC = WS_BIG + 144 * MiB, WS_VC = WS_BIG + 153 * MiB, WS_VT = WS_BIG + 162 * MiB, WS_U = WS_BIG;
constexpr size_t WS_GATES = 476 * MiB, WS_LOGF = 479 * MiB, WS_CUM = 480 * MiB, WS_KCC = 481 * MiB, WS_VCCT = WS_KCC + 512 * 1024, WS_HIDK = 482 * MiB, WS_HIDV = 484 * MiB, WS_END = 486 * MiB;
static_assert(WS_WB + (size_t)NB * DM * 2 <= WS_WO && WS_VT + (size_t)NB * T_TOK * 2 <= WS_BIG + 256 * MiB, "ws map");
constexpr int LDS_BYTES = 131072 + 1024;

#define LAS __attribute__((address_space(3)))
typedef unsigned short bf16_t;
typedef short bf16x8 __attribute__((ext_vector_type(8)));
typedef float f32x4 __attribute__((ext_vector_type(4)));
typedef float f32x16 __attribute__((ext_vector_type(16)));
typedef unsigned u32x4 __attribute__((ext_vector_type(4)));
typedef unsigned u32x2 __attribute__((ext_vector_type(2)));
typedef LAS unsigned char* lptr;

namespace pg8 {
__device__ __forceinline__ float gelu_tanh(float x) {
    const float u = 0.7978845608028654f * (x + 0.044715f * x * x * x);
    const float e = __expf(2.f * u);
    const float th = 1.f - 2.f / (e + 1.f);
    return 0.5f * x * (1.f + th);
}
template <int ACT> struct EpiStoreBf16 {
    static constexpr bool PERM = true, AFTER_DRAIN = false;
    bf16_t* O; size_t ldc; const float* bias;
    __device__ __forceinline__ void operator()(const f32x4 (&acc)[2][2][4][2], const Unit& u, int wr, int wc, int fr, int fq) const {
        asm volatile("" : "+v"(fr), "+v"(fq));
        const int row0 = u.pm * BM + wr * 64 + fr, col0 = u.pn * BM + wc * 32 + 8 * fq;
#pragma unroll
        for (int bj = 0; bj < 2; ++bj) {
            f32x4 b0 = (f32x4){0.f, 0.f, 0.f, 0.f}, b1 = b0;
            if (ACT == 2) { b0 = *(const f32x4*)(bias + col0 + bj * HALF); b1 = *(const f32x4*)(bias + col0 + bj * HALF + 4); }
#pragma unroll
            for (int ai = 0; ai < 2; ++ai)
#pragma unroll
                for (int m = 0; m < 4; ++m) {
                    f32x4 v0 = acc[ai][bj][m][0], v1 = acc[ai][bj][m][1];
                    if (ACT == 1) {
#pragma unroll
                        for (int e = 0; e < 4; ++e) { float a = fmaxf(v0[e], 0.f), b = fmaxf(v1[e], 0.f); v0[e] = a * a; v1[e] = b * b; }
                    }
                    if (ACT == 2) {
                        v0 += b0; v1 += b1;
#pragma unroll
                        for (int e = 0; e < 4; ++e) { v0[e] = gelu_tanh(v0[e]); v1[e] = gelu_tanh(v1[e]); }
                    }
                    u32x4 w; w.x = cvt_pk_bf16(v0[0], v0[1]); w.y = cvt_pk_bf16(v0[2], v0[3]); w.z = cvt_pk_bf16(v1[0], v1[1]); w.w = cvt_pk_bf16(v1[2], v1[3]);
                    *(u32x4*)(O + (size_t)(row0 + ai * HALF + m * 16) * ldc + col0 + bj * HALF) = w;
                }
        }
    }
};
struct EpiStoreF32 {
    static constexpr bool PERM = false, AFTER_DRAIN = false;
    float* O; size_t ldc;
    __device__ __forceinline__ void operator()(const f32x4 (&acc)[2][2][4][2], const Unit& u, int wr, int wc, int fr, int fq) const {
        asm volatile("" : "+v"(fr), "+v"(fq));
        const int row0 = u.pm * BM + wr * 64 + fr, col0 = u.pn * BM + wc * 32 + 4 * fq;
#pragma unroll
        for (int ai = 0; ai < 2; ++ai)
#pragma unroll
            for (int m = 0; m < 4; ++m) {
                float* rp = O + (size_t)(row0 + ai * HALF + m * 16) * ldc + col0;
#pragma unroll
                for (int bj = 0; bj < 2; ++bj)
#pragma unroll
                    for (int n = 0; n < 2; ++n) *(f32x4*)(rp + bj * HALF + n * 16) = acc[ai][bj][m][n];
            }
    }
};
struct EpiCmp2 {
    static constexpr bool PERM = false, AFTER_DRAIN = false;
    bf16_t* O; const float* b2; int transposed;
    __device__ __forceinline__ void operator()(const f32x4 (&acc)[2][2][4][2], const Unit& u, int wr, int wc, int fr, int fq) const {
        asm volatile("" : "+v"(fr), "+v"(fq));
        if (wc >= 2 || u.pn != 0) return;
#pragma unroll
        for (int n = 0; n < 2; ++n) {
            const int c0 = wc * 32 + 16 * n + 4 * fq;
            const f32x4 bv = *(const f32x4*)(b2 + c0);
#pragma unroll
            for (int ai = 0; ai < 2; ++ai)
#pragma unroll
                for (int m = 0; m < 4; ++m) {
                    const int row = u.pm * BM + ai * HALF + wr * 64 + m * 16 + fr, bg = row >> 8, nn = row & 255;
                    f32x4 v = acc[ai][0][m][n] + bv;
                    if (nn == 255) v = (f32x4){0.f, 0.f, 0.f, 0.f};
                    if (!transposed) { u32x2 w; w.x = cvt_pk_bf16(v[0], v[1]); w.y = cvt_pk_bf16(v[2], v[3]); *(u32x2*)(O + (size_t)row * 64 + c0) = w; }
                    else {
#pragma unroll
                        for (int e = 0; e < 4; ++e) O[((size_t)bg * 64 + c0 + e) * 256 + nn] = (bf16_t)(cvt_pk_bf16(v[e], 0.f) & 0xffffu);
                    }
                }
        }
    }
};
struct EpiIn {
    static constexpr bool PERM = true, AFTER_DRAIN = false;
    unsigned char* ws; const float* bgate; const float* bforget;
    static __device__ __forceinline__ u32x4 pack8(const f32x4& a, const f32x4& b, float s) {
        u32x4 w; w.x = cvt_pk_bf16(a[0] * s, a[1] * s); w.y = cvt_pk_bf16(a[2] * s, a[3] * s); w.z = cvt_pk_bf16(b[0] * s, b[1] * s); w.w = cvt_pk_bf16(b[2] * s, b[3] * s); return w;
    }
    __device__ __forceinline__ void rope8(f32x4& v0, f32x4& v1, int t, int fq) const {
        f32x4 p0, p1;
#pragma unroll
        for (int e = 0; e < 4; ++e) { p0[e] = __shfl_xor(v0[e], 16); p1[e] = __shfl_xor(v1[e], 16); }
        const f32x4* tb = (const f32x4*)((const float*)(ws + WS_ROPE) + (size_t)t * 16);
        const f32x4 c01 = tb[0], c23 = tb[1], c45 = tb[2], c67 = tb[3];
        f32x4 cA, sA, cB, sB;
        cA[0] = c01[0]; sA[0] = c01[1]; cA[1] = c01[2]; sA[1] = c01[3]; cA[2] = c23[0]; sA[2] = c23[1]; cA[3] = c23[2]; sA[3] = c23[3];
        cB[0] = c45[0]; sB[0] = c45[1]; cB[1] = c45[2]; sB[1] = c45[3]; cB[2] = c67[0]; sB[2] = c67[1]; cB[3] = c67[2]; sB[3] = c67[3];
        if (fq == 0) { v0 = v0 * cA - p0 * sA; v1 = v1 * cB - p1 * sB; }
        else if (fq == 1) { v0 = p0 * sA + v0 * cA; v1 = p1 * sB + v1 * cB; }
    }
    template <int CLS, int bj>
    __device__ __forceinline__ void emit(const f32x4 (&acc)[2][2][4][2], const Unit& u, int wr, int wc, int fr, int fq, int hc, int dl) const {
        const bool ropew = (wc & 1) == 0;
        bf16_t* QN = (bf16_t*)(ws + WS_QN); bf16_t* QR = (bf16_t*)(ws + WS_QR); bf16_t* KC = (bf16_t*)(ws + WS_KC); bf16_t* VC = (bf16_t*)(ws + WS_VC); bf16_t* KS = (bf16_t*)(ws + WS_KS); bf16_t* KW = (bf16_t*)(ws + WS_KW);
        bf16_t* FQ = (bf16_t*)(ws + WS_FQ); bf16_t* FK = (bf16_t*)(ws + WS_FK); float* GATES = (float*)(ws + WS_GATES); float* LOGF = (float*)(ws + WS_LOGF);
        (void)QN; (void)QR; (void)KC; (void)VC; (void)KS; (void)KW; (void)FQ; (void)FK; (void)GATES; (void)LOGF; (void)ropew;
#pragma unroll
        for (int ai = 0; ai < 2; ++ai)
#pragma unroll
            for (int m = 0; m < 4; ++m) {
                const int row = u.pm * BM + ai * HALF + wr * 64 + m * 16 + fr;
                const int bb = row >> 12, t = row & 4095;
                f32x4 v0 = acc[ai][bj][m][0], v1 = acc[ai][bj][m][1];
                if (CLS == 0) {
                    const size_t off = (size_t)row * 512 + hc * 64 + dl;
                    *(u32x4*)(QN + off) = pack8(v0, v1, QSCALE);
                    if (ropew) rope8(v0, v1, t, fq);
                    *(u32x4*)(QR + off) = pack8(v0, v1, QSCALE);
                } else if (CLS == 1) {
                    bf16_t* B = (hc < 10) ? KC : VC;
                    *(u32x4*)(B + ((size_t)(bb * 2 + (hc & 1)) * 4096 + t) * 64 + dl) = pack8(v0, v1, 1.f);
                } else if (CLS == 2) {
                    bf16_t* B = (hc < 14) ? KS : KW;
                    if (ropew) rope8(v0, v1, t, fq);
                    *(u32x4*)(B + (size_t)row * 128 + (hc & 1) * 64 + dl) = pack8(v0, v1, 1.f);
                } else if (CLS == 3) {
                    *(u32x4*)(FQ + (size_t)row * 512 + (hc - 16) * 64 + dl) = pack8(v0, v1, QSCALE);
                } else if (CLS == 4) {
                    *(u32x4*)(FK + (size_t)row * 512 + (hc - 24) * 64 + dl) = pack8(v0, v1, 1.f);
                } else {
                    if (fq < 3) {
                        const f32x4 g0 = *(const f32x4*)(bgate + 8 * fq), g1 = *(const f32x4*)(bgate + 8 * fq + 4);
                        f32x4 o0, o1;
#pragma unroll
                        for (int e = 0; e < 4; ++e) { o0[e] = 1.f / (1.f + __expf(-(v0[e] + g0[e]))); o1[e] = 1.f / (1.f + __expf(-(v1[e] + g1[e]))); }
                        *(f32x4*)(GATES + (size_t)row * 24 + 8 * fq) = o0; *(f32x4*)(GATES + (size_t)row * 24 + 8 * fq + 4) = o1;
                    } else {
                        const f32x4 g0 = *(const f32x4*)(bforget), g1 = *(const f32x4*)(bforget + 4);
                        f32x4 o0, o1;
#pragma unroll
                        for (int e = 0; e < 4; ++e) {
                            const float a = v0[e] + g0[e], b = v1[e] + g1[e];
                            o0[e] = fminf(a, 0.f) - log1pf(__expf(-fabsf(a))); o1[e] = fminf(b, 0.f) - log1pf(__expf(-fabsf(b)));
                        }
                        *(f32x4*)(LOGF + (size_t)row * 8) = o0; *(f32x4*)(LOGF + (size_t)row * 8 + 4) = o1;
                    }
                }
                asm volatile("" ::: "memory");
                __builtin_amdgcn_sched_barrier(0);
            }
    }
    template <int bj>
    __device__ __forceinline__ void half(const f32x4 (&acc)[2][2][4][2], const Unit& u, int wr, int wc, int fr, int fq) const {
        const int colb = u.pn * BM + bj * HALF + wc * 32, hc = colb >> 6;
        const int dl = (colb & 63) + 8 * fq;
        if (hc < 8) emit<0, bj>(acc, u, wr, wc, fr, fq, hc, dl);
        else if (hc < 12) emit<1, bj>(acc, u, wr, wc, fr, fq, hc, dl);
        else if (hc < 16) emit<2, bj>(acc, u, wr, wc, fr, fq, hc, dl);
        else if (hc < 24) emit<3, bj>(acc, u, wr, wc, fr, fq, hc, dl);
        else if (hc < 32) emit<4, bj>(acc, u, wr, wc, fr, fq, hc, dl);
        else if (hc == 32 && wc == 0) emit<5, bj>(acc, u, wr, wc, fr, fq, hc, dl);
    }
    __device__ __forceinline__ void operator()(const f32x4 (&acc)[2][2][4][2], const Unit& u, int wr, int wc, int fr, int fq) const {
        asm volatile("" : "+v"(fr), "+v"(fq));
        half<0>(acc, u, wr, wc, fr, fq);
        half<1>(acc, u, wr, wc, fr, fq);
    }
};
struct RangeOrder {
    int nM, nN, G, cc;
    __device__ void init(int M, int N, int G_, int c, int c0) { nM = M / BM; nN = N / BM; G = G_; cc = ((c - c0) % G_ + G_) % G_; }
    __device__ bool next(int i, Unit& u) const { const long L = (long)i * G + cc; if (L >= (long)nM * nN) return false; u.pm = (int)(L % nM); u.pn = (int)(L / nM); return true; }
    __device__ __forceinline__ void a_ready(const Unit&) const {}
    __device__ __forceinline__ void done(const Unit&) const {}
};
}

namespace att {
typedef float f32x2_t __attribute__((ext_vector_type(2)));
typedef __bf16 bf16x2_t __attribute__((ext_vector_type(2)));
constexpr int KROW = 144, TILEB = 64 * KROW;
constexpr int L_K = 0, L_V = 2 * TILEB, L_CK = 4 * TILEB, L_SELM = L_CK + 512, L_UNIT = L_SELM + 512, L_TOPK = L_UNIT + 64, L_IMP = 40960, L_END = L_IMP + 65536;
static_assert(L_TOPK + 2048 <= L_IMP && L_END <= 131072, "attention LDS map");
#define NEG_INF_F (-__builtin_inff())
__device__ __forceinline__ unsigned cvtpk(float lo, float hi) { f32x2_t v = {lo, hi}; bf16x2_t b = __builtin_convertvector(v, bf16x2_t); return __builtin_bit_cast(unsigned, b); }
__device__ __forceinline__ float hmax(float v) { auto rr = __builtin_amdgcn_permlane32_swap(__float_as_uint(v), __float_as_uint(v), false, false); return fmaxf(__uint_as_float(rr[0]), __uint_as_float(rr[1])); }
__device__ __forceinline__ float hsum(float v) { auto rr = __builtin_amdgcn_permlane32_swap(__float_as_uint(v), __float_as_uint(v), false, false); return __uint_as_float(rr[0]) + __uint_as_float(rr[1]); }
#define MFMA32(a, b, c) __builtin_amdgcn_mfma_f32_32x32x16_bf16((a), (b), (c), 0, 0, 0)

constexpr float RESC_THR = 8.f;
struct St { float mhat, thr, l; f32x16 negm, o0, o1; };
__device__ __forceinline__ void st_init(St& s) { s.mhat = 0.f; s.thr = -1e30f; s.l = 0.f; s.negm = (f32x16){}; s.o0 = (f32x16){}; s.o1 = (f32x16){}; }

template <bool FOXB>
__device__ __forceinline__ void tile_qk(f32x16& s0, f32x16& s1, const f32x16& cinit, lptr kb, lptr ck, const bf16x8 (&qf)[4], int koff, int hh) {
#pragma unroll
    for (int d0 = 0; d0 < 4; ++d0) {
        const bf16x8 a0 = *(const LAS bf16x8*)(kb + koff + d0 * 32);
        const bf16x8 a1 = *(const LAS bf16x8*)(kb + koff + 32 * KROW + d0 * 32);
        if (d0 == 0) { s0 = MFMA32(a0, qf[0], cinit); s1 = MFMA32(a1, qf[0], cinit); }
        else { s0 = MFMA32(a0, qf[d0], s0); s1 = MFMA32(a1, qf[d0], s1); }
    }
    __builtin_amdgcn_sched_barrier(0);
    if (FOXB) {
#pragma unroll
        for (int g = 0; g < 4; ++g) {
            const f32x4 c0 = *(const LAS f32x4*)(ck + 64 * hh + 16 * g), c1 = *(const LAS f32x4*)(ck + 128 + 64 * hh + 16 * g);
#pragma unroll
            for (int e = 0; e < 4; ++e) { s0[4 * g + e] -= c0[e]; s1[4 * g + e] -= c1[e]; }
        }
    }
}
__device__ __forceinline__ void tile_mask(f32x16& s0, f32x16& s1, int thr_le, int thr_gt, int hh) {
    const int tl = thr_le - 16 * hh, tg = thr_gt - 16 * hh;
#pragma unroll
    for (int r = 0; r < 16; ++r) {
        s0[r] = (r <= tl && r > tg) ? s0[r] : NEG_INF_F;
        s1[r] = (r + 32 <= tl && r + 32 > tg) ? s1[r] : NEG_INF_F;
    }
}
template <bool LANEMASK>
__device__ __forceinline__ void tile_softmax_pv(f32x16& s0, f32x16& s1, St& st, lptr vb, int voff, bool keep) {
    float ma = __builtin_fmaxf(__builtin_fmaxf(s0[0], s0[1]), s1[0]), mb = __builtin_fmaxf(__builtin_fmaxf(s0[2], s0[3]), s1[1]);
    ma = __builtin_fmaxf(__builtin_fmaxf(ma, s1[2]), s1[3]);
#pragma unroll
    for (int r = 4; r < 16; r += 4) {
        ma = __builtin_fmaxf(__builtin_fmaxf(ma, s0[r]), s0[r + 1]); mb = __builtin_fmaxf(__builtin_fmaxf(mb, s0[r + 2]), s0[r + 3]);
        ma = __builtin_fmaxf(__builtin_fmaxf(ma, s1[r]), s1[r + 1]); mb = __builtin_fmaxf(__builtin_fmaxf(mb, s1[r + 2]), s1[r + 3]);
    }
    float mx = hmax(__builtin_fmaxf(ma, mb));
    if (LANEMASK) mx = keep ? mx : NEG_INF_F;
    const bool need = mx > st.thr;
    if (__any(need)) {
        const float dl = need ? mx : 0.f;
        const float f = (need && st.thr > -1e29f) ? __builtin_amdgcn_exp2f(-dl) : 1.f;
        st.mhat += dl;
#pragma unroll
        for (int r = 0; r < 16; ++r) { s0[r] -= dl; s1[r] -= dl; }
        st.l *= f; st.o0 *= f; st.o1 *= f;
        const float nm = -st.mhat;
#pragma unroll
        for (int r = 0; r < 16; ++r) st.negm[r] = nm;
        st.thr = need ? RESC_THR : st.thr;
    }
    float rs = 0.f;
#pragma unroll
    for (int r = 0; r < 16; ++r) { s0[r] = __builtin_amdgcn_exp2f(s0[r]); s1[r] = __builtin_amdgcn_exp2f(s1[r]); rs += s0[r] + s1[r]; }
    if (LANEMASK) rs = keep ? rs : 0.f;
    st.l += rs;
    __builtin_amdgcn_sched_barrier(0);
#pragma unroll
    for (int kbk = 0; kbk < 2; ++kbk)
#pragma unroll
        for (int s = 0; s < 2; ++s) {
            u32x4 pw;
            if (kbk == 0) { pw.x = cvtpk(s0[8 * s], s0[8 * s + 1]); pw.y = cvtpk(s0[8 * s + 2], s0[8 * s + 3]); pw.z = cvtpk(s0[8 * s + 4], s0[8 * s + 5]); pw.w = cvtpk(s0[8 * s + 6], s0[8 * s + 7]); }
            else          { pw.x = cvtpk(s1[8 * s], s1[8 * s + 1]); pw.y = cvtpk(s1[8 * s + 2], s1[8 * s + 3]); pw.z = cvtpk(s1[8 * s + 4], s1[8 * s + 5]); pw.w = cvtpk(s1[8 * s + 6], s1[8 * s + 7]); }
            if (LANEMASK) { pw.x = keep ? pw.x : 0u; pw.y = keep ? pw.y : 0u; pw.z = keep ? pw.z : 0u; pw.w = keep ? pw.w : 0u; }
            const bf16x8 p = __builtin_bit_cast(bf16x8, pw);
            const bf16x8 a0 = *(const LAS bf16x8*)(vb + voff + kbk * 64 + s * 16);
            const bf16x8 a1 = *(const LAS bf16x8*)(vb + voff + 32 * KROW + kbk * 64 + s * 16);
            st.o0 = MFMA32(a0, p, st.o0); st.o1 = MFMA32(a1, p, st.o1);
        }
}
__device__ __forceinline__ void tile_imp(const f32x16& s0, const f32x16& s1, float minv, int thr, int t, lptr impw, int r32, int hh) {
#pragma unroll
    for (int kbk = 0; kbk < 2; ++kbk) {
        float p[16];
#pragma unroll
        for (int r = 0; r < 16; ++r) { const float sv = kbk ? s1[r] : s0[r]; p[r] = (32 * kbk + r <= thr - 16 * hh) ? __builtin_amdgcn_exp2f(sv) * minv : 0.f; }
        f32x4 add;
        add[0] = p[0] + p[1] + p[2] + 0.5f * p[3];
        add[1] = p[4] + p[5] + p[6] + 0.5f * p[7] + 0.5f * p[3];
        add[2] = p[8] + p[9] + p[10] + 0.5f * p[11] + 0.5f * p[7];
        add[3] = p[12] + p[13] + p[14] + 0.5f * p[15] + 0.5f * p[11];
        const float carry = 0.5f * p[15];
        const int j0 = 16 * t + 8 * kbk + 4 * hh;
        LAS f32x4* ip = (LAS f32x4*)(impw + (r32 * 64 + j0) * 4);
        f32x4 cur = *ip; cur += add; *ip = cur;
        asm volatile("s_waitcnt lgkmcnt(0)" ::: "memory");
        if (j0 + 4 < 64) { LAS float* cp = (LAS float*)(impw + (r32 * 64 + j0 + 4) * 4); const float c = *cp; *cp = c + carry; }
        asm volatile("s_waitcnt lgkmcnt(0)" ::: "memory");
    }
}

struct TP { const bf16_t* Kg; int kstride; const bf16_t* Vg; size_t vstride; const float* cum; int pt, ql, td, nmaxq; unsigned long long selm; float minv; lptr impw; };
enum { M_FOX = 0, M_WIN = 1, M_SEL = 2, M_CMPA = 3, M_CMPB = 4 };

template <int MODE>
__device__ __forceinline__ void run_tiles(lptr lds, unsigned long long tilemask, const TP& P, const bf16x8 (&qf)[4], St& st, int tid, int lane) {
    const int r32 = lane & 31, hh = lane >> 5;
    const int pi = (r32 & 3) | (((r32 >> 3) & 1) << 2) | (((r32 >> 4) & 1) << 3) | (((r32 >> 2) & 1) << 4);
    const int koff = pi * KROW + 16 * hh, voff = r32 * KROW + 32 * hh;
    const int srow = tid >> 3, sch = tid & 7;
    const bf16_t* kg = P.Kg + (size_t)srow * P.kstride + sch * 8;
    const bf16_t* vg = P.Vg + (size_t)srow * P.vstride + sch * 8;
    const int soff = srow * KROW + sch * 16;
    constexpr bool DESC = (MODE == M_FOX);
    unsigned long long rem = tilemask;
    int t;
    if (DESC) { t = 63 - __builtin_clzll(rem); rem &= ~(1ull << t); } else { t = __builtin_ctzll(rem); rem &= rem - 1ull; }
    int buf = 0;
    {
        const u32x4 kr = *(const u32x4*)(kg + (size_t)(64 * t) * P.kstride);
        const u32x4 vr = *(const u32x4*)(vg + 64 * t);
        float cr = 0.f; if (MODE == M_FOX && tid < 64) cr = P.cum[64 * t + tid];
        *(LAS u32x4*)(lds + L_K + soff) = kr; *(LAS u32x4*)(lds + L_V + soff) = vr;
        if (MODE == M_FOX && tid < 64) *(LAS float*)(lds + L_CK + tid * 4) = cr;
    }
    __syncthreads();
    for (;;) {
        const bool more = rem != 0ull;
        int tn = 0;
        if (more) { if (DESC) { tn = 63 - __builtin_clzll(rem); rem &= ~(1ull << tn); } else { tn = __builtin_ctzll(rem); rem &= rem - 1ull; } }
        u32x4 kr = (u32x4){0u, 0u, 0u, 0u}, vr = kr; float cr = 0.f;
        if (more) {
            kr = *(const u32x4*)(kg + (size_t)(64 * tn) * P.kstride);
            vr = *(const u32x4*)(vg + 64 * tn);
            if (MODE == M_FOX && tid < 64) cr = P.cum[64 * tn + tid];
        }
        {
            lptr kb = lds + L_K + buf * TILEB, vb = lds + L_V + buf * TILEB, ck = lds + L_CK + buf * 256;
            f32x16 s0, s1;
            if (MODE == M_FOX) {
                if (t <= P.td) {
                    tile_qk<true>(s0, s1, st.negm, kb, ck, qf, koff, hh);
                    if (t == P.td) tile_mask(s0, s1, P.ql, -1, hh);
                    tile_softmax_pv<false>(s0, s1, st, vb, voff, true);
                }
            } else if (MODE == M_WIN) {
                tile_qk<false>(s0, s1, st.negm, kb, ck, qf, koff, hh);
                if (t == P.pt) tile_mask(s0, s1, P.ql, -1, hh);
                else if (t == P.pt - 8) tile_mask(s0, s1, 63, P.ql, hh);
                tile_softmax_pv<false>(s0, s1, st, vb, voff, true);
            } else if (MODE == M_SEL) {
                const int bit = (int)((P.selm >> t) & 1ull);
                if (__any(bit)) {
                    tile_qk<false>(s0, s1, st.negm, kb, ck, qf, koff, hh);
                    if (t == P.pt) tile_mask(s0, s1, P.ql, -1, hh);
                    tile_softmax_pv<true>(s0, s1, st, vb, voff, bit != 0);
                }
            } else if (MODE == M_CMPA) {
                int thr = P.nmaxq - 64 * t; thr = thr < -1 ? -1 : (thr > 63 ? 63 : thr);
                tile_qk<false>(s0, s1, st.negm, kb, ck, qf, koff, hh);
                tile_mask(s0, s1, thr, -1, hh);
                tile_softmax_pv<false>(s0, s1, st, vb, voff, true);
            } else {
                int thr = P.nmaxq - 64 * t; thr = thr < -1 ? -1 : (thr > 63 ? 63 : thr);
                tile_qk<false>(s0, s1, st.negm, kb, ck, qf, koff, hh);
                tile_imp(s0, s1, P.minv, thr, t, P.impw, r32, hh);
            }
        }
        if (more) {
            const int nb = buf ^ 1;
            *(LAS u32x4*)(lds + L_K + nb * TILEB + soff) = kr; *(LAS u32x4*)(lds + L_V + nb * TILEB + soff) = vr;
            if (MODE == M_FOX && tid < 64) *(LAS float*)(lds + L_CK + nb * 256 + tid * 4) = cr;
        }
        __syncthreads();
        if (!more) break;
        t = tn; buf ^= 1;
    }
}

__device__ __forceinline__ void load_q(bf16x8 (&qf)[4], const bf16_t* qrow, int hh) {
#pragma unroll
    for (int d0 = 0; d0 < 4; ++d0) qf[d0] = *(const bf16x8*)(qrow + d0 * 16 + hh * 8);
}
__device__ __forceinline__ void store_o(bf16_t* op, const f32x16& a0, const f32x16& a1, int hh) {
#pragma unroll
    for (int g = 0; g < 4; ++g) {
        u32x2 w0, w1;
        w0.x = cvtpk(a0[4 * g], a0[4 * g + 1]); w0.y = cvtpk(a0[4 * g + 2], a0[4 * g + 3]);
        w1.x = cvtpk(a1[4 * g], a1[4 * g + 1]); w1.y = cvtpk(a1[4 * g + 2], a1[4 * g + 3]);
        *(u32x2*)(op + 8 * g + 4 * hh) = w0; *(u32x2*)(op + 32 + 8 * g + 4 * hh) = w1;
    }
}


__device__ __forceinline__ void accl_set(lptr aw, const f32x16& o0, const f32x16& o1, float sc, int r32, int hh) {
#pragma unroll
    for (int g = 0; g < 4; ++g) {
        const f32x4 a = (f32x4){o0[4 * g], o0[4 * g + 1], o0[4 * g + 2], o0[4 * g + 3]} * sc;
        const f32x4 b = (f32x4){o1[4 * g], o1[4 * g + 1], o1[4 * g + 2], o1[4 * g + 3]} * sc;
        *(LAS f32x4*)(aw + ((2 * g + hh) * 32 + r32) * 16) = a;
        *(LAS f32x4*)(aw + ((8 + 2 * g + hh) * 32 + r32) * 16) = b;
    }
}
__device__ __forceinline__ void accl_add(lptr aw, const f32x16& o0, const f32x16& o1, float sc, int r32, int hh) {
#pragma unroll
    for (int g = 0; g < 4; ++g) {
        const f32x4 a = (f32x4){o0[4 * g], o0[4 * g + 1], o0[4 * g + 2], o0[4 * g + 3]} * sc;
        const f32x4 b = (f32x4){o1[4 * g], o1[4 * g + 1], o1[4 * g + 2], o1[4 * g + 3]} * sc;
        LAS f32x4* pa = (LAS f32x4*)(aw + ((2 * g + hh) * 32 + r32) * 16);
        LAS f32x4* pb = (LAS f32x4*)(aw + ((8 + 2 * g + hh) * 32 + r32) * 16);
        *pa = *pa + a; *pb = *pb + b;
    }
}
__device__ __forceinline__ void accl_final_store(lptr aw, bf16_t* op, const f32x16& o0, const f32x16& o1, float sc, int r32, int hh) {
#pragma unroll
    for (int g = 0; g < 4; ++g) {
        const f32x4 a = (f32x4){o0[4 * g], o0[4 * g + 1], o0[4 * g + 2], o0[4 * g + 3]} * sc + *(const LAS f32x4*)(aw + ((2 * g + hh) * 32 + r32) * 16);
        const f32x4 b = (f32x4){o1[4 * g], o1[4 * g + 1], o1[4 * g + 2], o1[4 * g + 3]} * sc + *(const LAS f32x4*)(aw + ((8 + 2 * g + hh) * 32 + r32) * 16);
        u32x2 w0, w1;
        w0.x = cvtpk(a[0], a[1]); w0.y = cvtpk(a[2], a[3]); w1.x = cvtpk(b[0], b[1]); w1.y = cvtpk(b[2], b[3]);
        *(u32x2*)(op + 8 * g + 4 * hh) = w0; *(u32x2*)(op + 32 + 8 * g + 4 * hh) = w1;
    }
}

struct Bufs { const bf16_t *QN, *QR, *FQ, *FK, *KS, *KW, *VT, *KCC, *VCCT; const float *GATES, *CUM; bf16_t* MIXB; };

__device__ __forceinline__ void fox_unit(lptr lds, const Bufs& B, int b, int h, int qb, int tid, int lane, int w) {
    const int r32 = lane & 31, hh = lane >> 5;
    const int row = 256 * qb + 32 * w + r32; const size_t tok = (size_t)b * SEQ + row;
    bf16x8 qf[4]; load_q(qf, B.FQ + tok * 512 + h * 64, hh);
    TP P{}; P.Kg = B.FK + (size_t)b * SEQ * 512 + h * 64; P.kstride = 512; P.Vg = B.VT + (size_t)(256 + h * 64) * T_TOK + (size_t)b * SEQ; P.vstride = T_TOK;
    P.cum = B.CUM + (size_t)(b * 8 + h) * SEQ; P.td = 4 * qb + (w >> 1); P.ql = 32 * (w & 1) + r32; P.pt = 0; P.nmaxq = 0; P.selm = 0ull; P.minv = 0.f; P.impw = lds;
    const int ntile = 4 * qb + 4;
    const unsigned long long tm = ntile >= 64 ? ~0ull : ((1ull << ntile) - 1ull);
    St st; st_init(st);
    run_tiles<M_FOX>(lds, tm, P, qf, st, tid, lane);
    const float lt = hsum(st.l), inv = lt > 0.f ? 1.f / lt : 0.f;
    st.o0 *= inv; st.o1 *= inv;
    store_o(B.MIXB + tok * 1024 + 512 + h * 64, st.o0, st.o1, hh);
}

__device__ __forceinline__ void nsa_unit(lptr lds, const Bufs& B, int b, int g, int pt, int tid, int lane, int w) {
    const int r32 = lane & 31, hh = lane >> 5;
    const int hq = 4 * g + (w & 3), psub = w >> 2, ql = 32 * psub + r32, qpos = 64 * pt + ql;
    const size_t tok = (size_t)b * SEQ + qpos;
    const float* gp = B.GATES + tok * 24 + hq * 3;
    const float g_cmp = gp[0], g_sel = gp[1], g_win = gp[2];
    bf16x8 qf[4];
    TP P{}; P.pt = pt; P.ql = ql; P.td = 0; P.cum = nullptr; P.selm = 0ull; P.minv = 0.f;
    P.impw = lds + L_IMP + w * 8192;
    {
        load_q(qf, B.QN + tok * 512 + hq * 64, hh);
        P.Kg = B.KCC + (size_t)(b * 2 + g) * 256 * 64; P.kstride = 64; P.Vg = B.VCCT + (size_t)(b * 2 + g) * 64 * 256; P.vstride = 256;
        P.nmaxq = (qpos - 31) >> 4;
        const int ntc = (4 * pt + 2) / 64 + 1;
        const unsigned long long tm = (1ull << ntc) - 1ull;
        St st; st_init(st);
        run_tiles<M_CMPA>(lds, tm, P, qf, st, tid, lane);
        const float lt = hsum(st.l), inv = lt > 0.f ? 1.f / lt : 0.f;
        const float sc = inv * g_cmp;
        f32x16 c0 = st.o0 * sc, c1 = st.o1 * sc;
        if (pt >= 16) {
            LAS f32x4* z = (LAS f32x4*)(P.impw);
#pragma unroll
            for (int i = 0; i < 8; ++i) z[i * 64 + lane] = (f32x4){0.f, 0.f, 0.f, 0.f};
            asm volatile("s_waitcnt lgkmcnt(0)" ::: "memory");
            P.minv = inv;
            run_tiles<M_CMPB>(lds, tm, P, qf, st, tid, lane);
#pragma unroll 1
            for (int i = 0; i < 8; ++i) {
                const int p = w * 8 + i;
                float v = 0.f;
#pragma unroll
                for (int h4 = 0; h4 < 4; ++h4) v += *(const LAS float*)(lds + L_IMP + ((p >> 5) * 4 + h4) * 8192 + ((p & 31) * 64 + lane) * 4);
                const bool elig = lane >= 1 && lane <= pt - 2;
                const float vv = elig ? v : -1.f;
                LAS float* trow = (LAS float*)(lds + L_TOPK + w * 256);
                trow[lane] = vv;
                asm volatile("s_waitcnt lgkmcnt(0)" ::: "memory");
                int rank = 0;
#pragma unroll 4
                for (int c = 0; c < 16; ++c) {
                    const f32x4 o = *(const LAS f32x4*)(trow + 4 * c);
#pragma unroll
                    for (int e = 0; e < 4; ++e) rank += (o[e] > vv || (o[e] == vv && (4 * c + e) < lane)) ? 1 : 0;
                }
                asm volatile("s_waitcnt lgkmcnt(0)" ::: "memory");
                const bool sel = elig && rank < 13;
                const unsigned long long mk = __ballot(sel) | 1ull | (1ull << pt) | (1ull << (pt - 1));
                if (lane == 0) *(LAS unsigned long long*)(lds + L_SELM + p * 8) = mk;
            }
        } else {
            if (tid < 64) *(LAS unsigned long long*)(lds + L_SELM + tid * 8) = (2ull << pt) - 1ull;
        }
        __syncthreads();
        accl_set(P.impw, c0, c1, 1.f, r32, hh);
    }
    unsigned long long um;
    {
        const unsigned long long mine = *(const LAS unsigned long long*)(lds + L_SELM + lane * 8);
        unsigned lo = (unsigned)mine, hi = (unsigned)(mine >> 32);
#pragma unroll
        for (int o = 1; o < 64; o <<= 1) { lo |= __shfl_xor(lo, o); hi |= __shfl_xor(hi, o); }
        um = ((unsigned long long)hi << 32) | lo;
        P.selm = *(const LAS unsigned long long*)(lds + L_SELM + ql * 8);
    }
    load_q(qf, B.QR + tok * 512 + hq * 64, hh);
    {
        P.Kg = B.KW + (size_t)b * SEQ * 128 + g * 64; P.kstride = 128; P.Vg = B.VT + (size_t)(128 + g * 64) * T_TOK + (size_t)b * SEQ; P.vstride = T_TOK;
        const int t0 = pt >= 8 ? pt - 8 : 0;
        const unsigned long long tm = ((2ull << pt) - 1ull) & ~((1ull << t0) - 1ull);
        St st; st_init(st);
        run_tiles<M_WIN>(lds, tm, P, qf, st, tid, lane);
        const float lt = hsum(st.l), inv = lt > 0.f ? 1.f / lt : 0.f;
        accl_add(P.impw, st.o0, st.o1, inv * g_win, r32, hh);
    }
    {
        P.Kg = B.KS + (size_t)b * SEQ * 128 + g * 64; P.kstride = 128; P.Vg = B.VT + (size_t)(g * 64) * T_TOK + (size_t)b * SEQ; P.vstride = T_TOK;
        const unsigned long long tm = um & ((2ull << pt) - 1ull);
        St st; st_init(st);
        run_tiles<M_SEL>(lds, tm, P, qf, st, tid, lane);
        const float lt = hsum(st.l), inv = lt > 0.f ? 1.f / lt : 0.f;
        accl_final_store(P.impw, B.MIXB + tok * 1024 + hq * 64, st.o0, st.o1, inv * g_sel, r32, hh);
    }
}

struct UnitOrder { unsigned short u[2048]; };
constexpr UnitOrder make_order() {
    UnitOrder o{}; int fi = 0, ni = 0;
    for (int k = 0; k < 2048; ++k) {
        const int fcost = fi < 1024 ? 4 * (15 - fi / 64) + 4 : -1;
        const int ncost = ni < 1024 ? (63 - ni / 16) + 18 : -1;
        if (fcost >= ncost) { const int qb = 15 - fi / 64, bh = fi % 64; o.u[k] = (unsigned short)((qb << 6) | bh); ++fi; }
        else { const int pt = 63 - ni / 16, bg = ni % 16; o.u[k] = (unsigned short)(0x8000 | (pt << 4) | bg); ++ni; }
    }
    return o;
}
__device__ const UnitOrder g_order = make_order();

__device__ __forceinline__ void attention_phase(lptr lds, const Bufs& B, unsigned* ctr, int tid, int lane, int w) {
    for (;;) {
        if (tid == 0) *(LAS unsigned*)(lds + L_UNIT) = atomicAdd(ctr, 1u);
        __syncthreads();
        const unsigned k = *(const LAS unsigned*)(lds + L_UNIT);
        __syncthreads();
        if (k >= 2048u) break;
        const unsigned code = g_order.u[k];
        if (code & 0x8000u) nsa_unit(lds, B, (int)(code & 15u) >> 1, (int)(code & 1u), (int)((code >> 4) & 63u), tid, lane, w);
        else fox_unit(lds, B, (int)(code & 63u) >> 3, (int)(code & 7u), (int)((code >> 6) & 15u), tid, lane, w);
    }
}
}

__device__ __forceinline__ unsigned f2bf(float f) { unsigned u = __builtin_bit_cast(unsigned, f); return (u + 0x7fffu + ((u >> 16) & 1u)) >> 16; }
__device__ __forceinline__ unsigned pk2(float lo, float hi) { return f2bf(lo) | (f2bf(hi) << 16); }
__device__ __forceinline__ float wave_sum(float v) {
#pragma unroll
    for (int o = 1; o < 64; o <<= 1) v += __shfl_xor(v, o);
    return v;
}
__device__ __forceinline__ void tr_item(const float* W, int ldw, int srccol, int ncols, bf16_t* WT, int dstrow, int K, LAS float* scr, int item, int lane) {
    const int nblk = (ncols + 31) >> 5, kb = item / nblk, nb = item % nblk, k0 = 64 * kb, n0 = 32 * nb;
    const int nvalid = (ncols - n0) < 32 ? (ncols - n0) : 32;
    const int cl = lane & 31;
#pragma unroll 8
    for (int i = 0; i < 32; ++i) { const int kk = 2 * i + (lane >> 5); scr[kk * 33 + cl] = (cl < nvalid) ? W[(size_t)(k0 + kk) * ldw + srccol + n0 + cl] : 0.f; }
    asm volatile("s_waitcnt lgkmcnt(0)" ::: "memory");
    const int c = lane & 7;
#pragma unroll
    for (int j = 0; j < 4; ++j) {
        const int n = (lane >> 3) + 8 * j; const LAS float* s = scr + (8 * c) * 33 + n;
        u32x4 o; o.x = pk2(s[0 * 33], s[1 * 33]); o.y = pk2(s[2 * 33], s[3 * 33]); o.z = pk2(s[4 * 33], s[5 * 33]); o.w = pk2(s[6 * 33], s[7 * 33]);
        if (n < nvalid) *(u32x4*)(WT + (size_t)(dstrow + n0 + n) * K + k0 + 8 * c) = o;
    }
    asm volatile("s_waitcnt lgkmcnt(0)" ::: "memory");
}
__device__ __forceinline__ void norm_rows(const float* xin, const bf16_t* Y, const float* gpost, float* xout, bf16_t* HB, const float* gpre, int gw, int ngw, int lane) {
    for (int row = gw; row < T_TOK; row += ngw) {
        const f32x4* xr = (const f32x4*)(xin + (size_t)row * DM) + lane;
        f32x4 v[4];
#pragma unroll
        for (int j = 0; j < 4; ++j) v[j] = xr[64 * j];
        if (Y) {
            const u32x2* yr = (const u32x2*)(Y + (size_t)row * DM) + lane;
            f32x4 y[4]; float s = 0.f;
#pragma unroll
            for (int j = 0; j < 4; ++j) { const u32x2 yb = yr[64 * j]; y[j] = (f32x4){__uint_as_float(yb.x << 16), __uint_as_float(yb.x & 0xffff0000u), __uint_as_float(yb.y << 16), __uint_as_float(yb.y & 0xffff0000u)}; s += (y[j].x * y[j].x + y[j].y * y[j].y) + (y[j].z * y[j].z + y[j].w * y[j].w); }
            const float rstd = 1.0f / sqrtf(wave_sum(s) * (1.f / DM) + NORM_EPS);
#pragma unroll
            for (int j = 0; j < 4; ++j) { const f32x4 gg = *((const f32x4*)gpost + 64 * j + lane); v[j] += y[j] * rstd * gg; }
        }
        if (xout) {
            f32x4* xo = (f32x4*)(xout + (size_t)row * DM) + lane;
#pragma unroll
            for (int j = 0; j < 4; ++j) xo[64 * j] = v[j];
        }
        if (HB) {
            float s = 0.f;
#pragma unroll
            for (int j = 0; j < 4; ++j) s += (v[j].x * v[j].x + v[j].y * v[j].y) + (v[j].z * v[j].z + v[j].w * v[j].w);
            const float rstd = 1.0f / sqrtf(wave_sum(s) * (1.f / DM) + NORM_EPS);
            u32x2* ho = (u32x2*)(HB + (size_t)row * DM) + lane;
#pragma unroll
            for (int j = 0; j < 4; ++j) { const f32x4 gg = *((const f32x4*)gpre + 64 * j + lane); const f32x4 o = v[j] * rstd * gg; u32x2 w; w.x = pk2(o.x, o.y); w.y = pk2(o.z, o.w); ho[64 * j] = w; }
        }
    }
}

struct Args { const float* in[21]; float* out; unsigned char* ws; };
enum { I_X = 0, I_WIN, I_BGATE, I_BFORGET, I_POSK, I_W1K, I_B1K, I_W2K, I_B2K, I_POSV, I_W1V, I_B1V, I_W2V, I_B2V, I_WOUT, I_WUP, I_WDN, I_GPREMIX, I_GPOSTMIX, I_GPREMLP, I_GPOSTMLP };


#define CAS __attribute__((address_space(4)))
__device__ __forceinline__ const float* argp(int i) {
    const CAS char* kp = (const CAS char*)__builtin_amdgcn_kernarg_segment_ptr();
    asm volatile("" : "+s"(kp));
    return *(const float* const CAS*)(kp + 8 * i);
}
#define ARG(i) argp(i)
#define PHASE_PTRS() int tid = threadIdx.x; asm volatile("" : "+v"(tid)); const int lane = tid & 63, wave = __builtin_amdgcn_readfirstlane(tid >> 6); const int G = gridDim.x, bx = blockIdx.x; const int gw = bx * 8 + wave, NGW = G * 8; (void)lane; (void)gw; (void)NGW; \
    unsigned char* ws = (unsigned char*)argp(22); float* X = (float*)argp(21); (void)X; \
    bf16_t* WA = (bf16_t*)(ws + WS_WA); bf16_t* WB = (bf16_t*)(ws + WS_WB); bf16_t* WO = (bf16_t*)(ws + WS_WO); bf16_t* WUP = (bf16_t*)(ws + WS_WUP); bf16_t* WDN = (bf16_t*)(ws + WS_WDN); \
    bf16_t* W1K = (bf16_t*)(ws + WS_W1K); bf16_t* W1V = (bf16_t*)(ws + WS_W1V); bf16_t* W2K = (bf16_t*)(ws + WS_W2K); bf16_t* W2V = (bf16_t*)(ws + WS_W2V); \
    float* C1 = (float*)(ws + WS_C1); float* ROPE = (float*)(ws + WS_ROPE); \
    bf16_t* HB = (bf16_t*)(ws + WS_HB); bf16_t* Y = (bf16_t*)(ws + WS_Y); \
    bf16_t* QN = (bf16_t*)(ws + WS_QN); bf16_t* QR = (bf16_t*)(ws + WS_QR); bf16_t* FQ = (bf16_t*)(ws + WS_FQ); bf16_t* FK = (bf16_t*)(ws + WS_FK); \
    bf16_t* KS = (bf16_t*)(ws + WS_KS); bf16_t* KW = (bf16_t*)(ws + WS_KW); bf16_t* KC = (bf16_t*)(ws + WS_KC); bf16_t* VC = (bf16_t*)(ws + WS_VC); bf16_t* VT = (bf16_t*)(ws + WS_VT); \
    bf16_t* U = (bf16_t*)(ws + WS_U); \
    float* GATES = (float*)(ws + WS_GATES); float* LOGF = (float*)(ws + WS_LOGF); float* CUM = (float*)(ws + WS_CUM); \
    bf16_t* KCC = (bf16_t*)(ws + WS_KCC); bf16_t* VCCT = (bf16_t*)(ws + WS_VCCT); bf16_t* HIDK = (bf16_t*)(ws + WS_HIDK); bf16_t* HIDV = (bf16_t*)(ws + WS_HIDV); \
    unsigned* ctl = (unsigned*)(ws + WS_CTL); \
    (void)WA; (void)WB; (void)WO; (void)WUP; (void)WDN; (void)W1K; (void)W1V; (void)W2K; (void)W2V; (void)C1; (void)ROPE; (void)HB; (void)Y; (void)QN; (void)QR; (void)FQ; (void)FK; (void)KS; (void)KW; (void)KC; (void)VC; (void)VT; (void)U; (void)GATES; (void)LOGF; (void)CUM; (void)KCC; (void)VCCT; (void)HIDK; (void)HIDV; (void)ctl

__global__ void __launch_bounds__(512, 2) mega_fwd(Args a) {
    extern __shared__ __attribute__((aligned(16))) unsigned char lds_raw[];
    lptr lds = (lptr)lds_raw;
    cg::grid_group grid = cg::this_grid();

    {
        unsigned char* ws0 = (unsigned char*)argp(22);
        float* ROPE0 = (float*)(ws0 + WS_ROPE);
        const int gt = blockIdx.x * 512 + threadIdx.x;
        if (gt < 4096 * 8) {
            const int pos = gt >> 3, i = gt & 7;
            const float inv = powf(500000.f, -(float)i * 0.125f);
            const float ang = (float)pos * inv;
            ROPE0[gt * 2] = (float)cos((double)ang); ROPE0[gt * 2 + 1] = (float)sin((double)ang);
        }
    }
#pragma unroll 1
    for (int l = 0; l < NLAYER; ++l) {
        {
            PHASE_PTRS();
            const float* w_in = ARG(I_WIN) + (size_t)l * DM * WIN_COLS;
            const float* w_out = ARG(I_WOUT) + (size_t)l * DM * DM;
            const float* w_up = ARG(I_WUP) + (size_t)l * DM * DFF;
            const float* w_dn = ARG(I_WDN) + (size_t)l * DFF * DM;
            const float* w1k = ARG(I_W1K) + (size_t)l * 2048 * 256; const float* w1v = ARG(I_W1V) + (size_t)l * 2048 * 256;
            const float* w2k = ARG(I_W2K) + (size_t)l * 256 * 64; const float* w2v = ARG(I_W2V) + (size_t)l * 256 * 64;
            LAS float* scr = (LAS float*)(lds + wave * 8704);
            constexpr int NIT_IN = 16 * (16 + 4 + 4 + 4 + 4 + 16 + 16 + 1 + 1 + 4 + 4 + 16);
            constexpr int NITEMS = NIT_IN + 16 * 32 + 16 * 128 + 64 * 32 + 2 * 32 * 8 + 2 * 4 * 2;
            for (int it = gw; it < NITEMS; it += NGW) {
                int r = it;
#define SEG(Wp, ldw, srccol, ncols, WTp, dstrow, KK) { const int n_ = (((ncols) + 31) / 32) * ((KK) / 64); if (r < n_) { tr_item(Wp, ldw, srccol, ncols, WTp, dstrow, KK, scr, r, lane); continue; } r -= n_; }
                SEG(w_in, WIN_COLS, 0, 512, WA, 0, DM)
                SEG(w_in, WIN_COLS, 512, 128, WA, 512, DM)
                SEG(w_in, WIN_COLS, 640, 128, WA, 640, DM)
                SEG(w_in, WIN_COLS, 768, 128, WA, 768, DM)
                SEG(w_in, WIN_COLS, 1024, 128, WA, 896, DM)
                SEG(w_in, WIN_COLS, 1304, 512, WA, 1024, DM)
                SEG(w_in, WIN_COLS, 1816, 512, WA, 1536, DM)
                SEG(w_in, WIN_COLS, 1280, 24, WA, 2048, DM)
                SEG(w_in, WIN_COLS, 2840, 8, WA, 2072, DM)
                SEG(w_in, WIN_COLS, 896, 128, WB, 0, DM)
                SEG(w_in, WIN_COLS, 1152, 128, WB, 128, DM)
                SEG(w_in, WIN_COLS, 2328, 512, WB, 256, DM)
                SEG(w_out, DM, 0, DM, WO, 0, DM)
                SEG(w_up, DFF, 0, DFF, WUP, 0, DM)
                SEG(w_dn, DM, 0, DM, WDN, 0, DFF)
                SEG(w1k, 256, 0, 256, W1K, 0, 2048)
                SEG(w1v, 256, 0, 256, W1V, 0, 2048)
                SEG(w2k, 64, 0, 64, W2K, 0, 256)
                SEG(w2v, 64, 0, 64, W2V, 0, 256)
#undef SEG
            }
            {
                const int gt = bx * 512 + tid, ngt = G * 512;
                const u32x4 z = (u32x4){0u, 0u, 0u, 0u};
                for (int i = gt; i < 224 * 1024 / 8; i += ngt) *((u32x4*)(WA + (size_t)2080 * DM) + i) = z;
                for (int i = gt; i < 192 * 256 / 8; i += ngt) { *((u32x4*)(W2K + 64 * 256) + i) = z; *((u32x4*)(W2V + 64 * 256) + i) = z; }
            }
            for (int it = bx; it < 8; it += G) {
                const int kv = it >> 2, jb = it & 3, kc = tid >> 6, j = jb * 64 + (tid & 63);
                const float* pos = (kv ? ARG(I_POSV) : ARG(I_POSK)) + (size_t)l * 2048;
                const float* w1 = kv ? w1v : w1k;
                const float* b1 = (kv ? ARG(I_B1V) : ARG(I_B1K)) + (size_t)l * 256;
                float s = 0.f;
#pragma unroll 8
                for (int k = 256 * kc; k < 256 * kc + 256; ++k) s += pos[k] * w1[(size_t)k * 256 + j];
                LAS float* red = (LAS float*)(lds + 81920);
                red[tid] = s;
                __syncthreads();
                if (tid < 64) { float tot = b1[j]; for (int q = 0; q < 8; ++q) tot += red[q * 64 + tid]; C1[kv * 256 + j] = tot; }
                __syncthreads();
            }
            if (l == 0) norm_rows(ARG(I_X), nullptr, nullptr, X, HB, ARG(I_GPREMIX), gw, NGW, lane);
            else norm_rows(X, Y, ARG(I_GPOSTMLP) + (size_t)(l - 1) * DM, X, HB, ARG(I_GPREMIX) + (size_t)l * DM, gw, NGW, lane);
        }
        grid.sync();
        {
            PHASE_PTRS();
            pg8::Gemm g{HB, WA, T_TOK, NA, DM, DM}; pg8::StaticOrder S; S.init(T_TOK, NA, G, bx);
            pg8::EpiIn E{ws, ARG(I_BGATE) + l * 24, ARG(I_BFORGET) + l * 8};
            pg8::gemm_phase<pg8::EpiIn, pg8::StaticOrder, true, true>(lds, g, S, E);
            pg8::Gemm g2{WB, HB, NB, T_TOK, DM, DM}; pg8::StaticOrder S2; S2.init(NB, T_TOK, G, bx);
            pg8::EpiStoreBf16<0> E2{VT, (size_t)T_TOK, nullptr};
            pg8::gemm_phase<pg8::EpiStoreBf16<0>, pg8::StaticOrder, true, true>(lds, g2, S2, E2);
        }
        grid.sync();
        {
            PHASE_PTRS();
            pg8::Gemm gk{KC, W1K, 4096, 256, 2048, 1024}; pg8::RangeOrder Sk; Sk.init(4096, 256, G, bx, 0);
            pg8::EpiStoreBf16<2> Ek{HIDK, 256, C1};
            pg8::gemm_phase<pg8::EpiStoreBf16<2>, pg8::RangeOrder, false, true>(lds, gk, Sk, Ek);
            pg8::Gemm gv{VC, W1V, 4096, 256, 2048, 1024}; pg8::RangeOrder Sv; Sv.init(4096, 256, G, bx, 16 % G);
            pg8::EpiStoreBf16<2> Ev{HIDV, 256, C1 + 256};
            pg8::gemm_phase<pg8::EpiStoreBf16<2>, pg8::RangeOrder, false, true>(lds, gv, Sv, Ev);
            for (int task = ((bx - 32) % G + G) % G; task < 64; task += G) {
                const int b = task >> 3, h = task & 7;
                const float* lf = LOGF + ((size_t)b * SEQ + 8 * tid) * 8 + h;
                float v[8]; double s = 0.0;
#pragma unroll
                for (int i = 0; i < 8; ++i) { v[i] = lf[i * 8]; s += (double)v[i]; }
                double inc = s;
#pragma unroll
                for (int o = 1; o < 64; o <<= 1) { const double up = __shfl_up(inc, o); if (lane >= o) inc += up; }
                LAS double* wsum = (LAS double*)(lds + 1024);
                if (lane == 63) wsum[wave] = inc;
                __syncthreads();
                double base = 0.0;
                for (int q = 0; q < wave; ++q) base += wsum[q];
                double run = base + inc - s;
                f32x4 o0, o1;
#pragma unroll
                for (int i = 0; i < 4; ++i) { run += (double)v[i]; o0[i] = (float)run * LOG2E; }
#pragma unroll
                for (int i = 0; i < 4; ++i) { run += (double)v[4 + i]; o1[i] = (float)run * LOG2E; }
                float* co = CUM + (size_t)task * SEQ + 8 * tid;
                *(f32x4*)co = o0; *(f32x4*)(co + 4) = o1;
                __syncthreads();
            }
        }
        grid.sync();
        {
            PHASE_PTRS();
            pg8::Gemm gk{HIDK, W2K, 4096, 256, 256, 256}; pg8::RangeOrder Sk; Sk.init(4096, 256, G, bx, 0);
            pg8::EpiCmp2 Ek{KCC, ARG(I_B2K) + l * 64, 0};
            pg8::gemm_phase<pg8::EpiCmp2, pg8::RangeOrder, false, true>(lds, gk, Sk, Ek);
            pg8::Gemm gv{HIDV, W2V, 4096, 256, 256, 256}; pg8::RangeOrder Sv; Sv.init(4096, 256, G, bx, 16 % G);
            pg8::EpiCmp2 Ev{VCCT, ARG(I_B2V) + l * 64, 1};
            pg8::gemm_phase<pg8::EpiCmp2, pg8::RangeOrder, false, true>(lds, gv, Sv, Ev);
        }
        grid.sync();
        {
            PHASE_PTRS();
            att::Bufs B{QN, QR, FQ, FK, KS, KW, VT, KCC, VCCT, GATES, CUM, HB};
            att::attention_phase(lds, B, ctl + 64 * l, tid, lane, wave);
        }
        grid.sync();
        {
            PHASE_PTRS();
            pg8::Gemm g{HB, WO, T_TOK, DM, DM, DM}; pg8::StaticOrder S; S.init(T_TOK, DM, G, bx);
            pg8::EpiStoreBf16<0> E{Y, (size_t)DM, nullptr};
            pg8::gemm_phase<pg8::EpiStoreBf16<0>, pg8::StaticOrder, true, true>(lds, g, S, E);
        }
        grid.sync();
        { PHASE_PTRS(); norm_rows(X, Y, ARG(I_GPOSTMIX) + (size_t)l * DM, X, HB, ARG(I_GPREMLP) + (size_t)l * DM, gw, NGW, lane); }
        grid.sync();
        {
            PHASE_PTRS();
            pg8::Gemm g{HB, WUP, T_TOK, DFF, DM, DM}; pg8::StaticOrder S; S.init(T_TOK, DFF, G, bx);
            pg8::EpiStoreBf16<1> E{U, (size_t)DFF, nullptr};
            pg8::gemm_phase<pg8::EpiStoreBf16<1>, pg8::StaticOrder, true, true>(lds, g, S, E);
        }
        grid.sync();
        {
            PHASE_PTRS();
            pg8::Gemm g{U, WDN, T_TOK, DM, DFF, DFF}; pg8::StaticOrder S; S.init(T_TOK, DM, G, bx);
            pg8::EpiStoreBf16<0> E{Y, (size_t)DM, nullptr};
            pg8::gemm_phase<pg8::EpiStoreBf16<0>, pg8::StaticOrder, true, true>(lds, g, S, E);
        }
        grid.sync();
    }
    { PHASE_PTRS(); norm_rows(X, Y, ARG(I_GPOSTMLP) + (size_t)(NLAYER - 1) * DM, X, nullptr, nullptr, gw, NGW, lane); }
}

extern "C" void kernel_launch(void* const* d_in, const int* in_sizes, int n_in, void* d_out, int out_size, void* d_ws, size_t ws_size, hipStream_t stream) {
    static int grid = 0;
    if (grid == 0) {
        if (n_in != 21 || out_size != T_TOK * DM || ws_size < WS_END) { fprintf(stderr, "kernel_launch: unexpected shapes (n_in %d out %d ws %zu)\n", n_in, out_size, ws_size); grid = -1; return; }
        int dev = 0, cus = 0, per_cu = 0;
        hipGetDevice(&dev);
        hipDeviceGetAttribute(&cus, hipDeviceAttributeMultiprocessorCount, dev);
        if (hipFuncSetAttribute((const void*)mega_fwd, hipFuncAttributeMaxDynamicSharedMemorySize, LDS_BYTES) != hipSuccess) { fprintf(stderr, "kernel_launch: hipFuncSetAttribute failed\n"); grid = -1; return; }
        if (hipOccupancyMaxActiveBlocksPerMultiprocessor(&per_cu, (const void*)mega_fwd, 512, LDS_BYTES) != hipSuccess || per_cu < 1) { fprintf(stderr, "kernel_launch: occupancy query gives %d\n", per_cu); per_cu = 1; }
        (void)hipGetLastError();
        grid = cus * 1;
        if (grid < 64) grid = 64;
    }
    if (grid < 0) return;
    hipMemsetAsync((char*)d_ws + WS_CTL, 0, 4096, stream);
    Args a{};
    for (int i = 0; i < 21; ++i) a.in[i] = (const float*)d_in[i];
    a.out = (float*)d_out; a.ws = (unsigned char*)d_ws;
    void* args[] = {&a};
    hipError_t e = hipLaunchCooperativeKernel((const void*)mega_fwd, dim3(grid), dim3(512), args, LDS_BYTES, stream);
    if (e != hipSuccess) fprintf(stderr, "cooperative launch failed: %s (grid %d)\n", hipGetErrorString(e), grid);
}
```
